# Optimizing an MI355X kernel written in HIP

```python
import math
import jax
import jax.numpy as jnp
from jax import lax
import numpy as np

D_MODEL = 1024
BATCH = 8
SEQ = 2048
DEPTH = 4

GRID_W = 64
CTX_LEN = 256
N_MIXERS = 3
D_FF = 4 * D_MODEL
NORM_EPS = 1e-6
ROPE_BASE = 10000.0

A_HEADS = 8
A_DQK = D_MODEL // (2 * A_HEADS)
A_DV = D_MODEL // A_HEADS
A_CHUNK = 128
A_IN = 2 * A_HEADS * A_DQK + A_HEADS * A_DV + D_MODEL + 4 * A_HEADS

SWA_HEADS = 16
SWA_KV_HEADS = 4
SWA_DH = D_MODEL // SWA_HEADS
SWA_GROUP = SWA_HEADS // SWA_KV_HEADS
WINDOW = 128
SWA_BLOCK = WINDOW
SWA_IN = (SWA_HEADS + 2 * SWA_KV_HEADS) * SWA_DH

DIFF_HEADS = 8
DIFF_DH = D_MODEL // (2 * DIFF_HEADS)
DIFF_DV = 2 * DIFF_DH
DIFF_BLOCK = 128
DIFF_IN = 4 * DIFF_HEADS * DIFF_DH + DIFF_HEADS * DIFF_DV

N_MLSTM = (DEPTH + N_MIXERS - 1) // N_MIXERS
N_SWA = (DEPTH + N_MIXERS - 2) // N_MIXERS
N_DIFF = (DEPTH + N_MIXERS - 3) // N_MIXERS

kernel_name = "hybrid_mlstm_swa_diffattn_prefix_trunk"

F32 = jnp.float32


def _rms_norm(x, g):
    xf = x.astype(F32)
    y = xf * lax.rsqrt(jnp.mean(xf * xf, axis=-1, keepdims=True) + NORM_EPS)
    return (y * g.astype(F32)).astype(x.dtype)


def _modulate(x, shift, scale):
    return x * (1.0 + scale) + shift


def _sq_relu_mlp(u, w1, w2):
    return jnp.square(jax.nn.relu(u @ w1)) @ w2


def _axial_rope_tables(n_tok, head_dim):
    rows = n_tok // GRID_W
    row = jnp.repeat(jnp.arange(rows, dtype=jnp.int32), GRID_W).astype(F32)
    col = jnp.tile(jnp.arange(GRID_W, dtype=jnp.int32), rows).astype(F32)
    quarter = head_dim // 4
    inv = ROPE_BASE ** (-jnp.arange(quarter, dtype=F32) / quarter)
    ang = jnp.concatenate([row[:, None] * inv, col[:, None] * inv], axis=-1)
    return jnp.cos(ang), jnp.sin(ang)


def _apply_rope(x, cos, sin):
    half = x.shape[-1] // 2
    x1, x2 = x[..., :half], x[..., half:]
    cs = cos[:, None, :].astype(x.dtype)
    sn = sin[:, None, :].astype(x.dtype)
    return jnp.concatenate([x1 * cs - x2 * sn, x1 * sn + x2 * cs], axis=-1)


def _to_chunks(t):
    bsz, n, h = t.shape[:3]
    t = t.reshape((bsz, n // A_CHUNK, A_CHUNK, h) + t.shape[3:])
    return jnp.moveaxis(t, 3, 1)


def _from_chunks(t):
    t = jnp.moveaxis(t, 1, 3)
    return t.reshape((t.shape[0], t.shape[1] * t.shape[2]) + t.shape[3:])


def _mlstm_direction(q, k, v, log_i, log_f, state, need_out):
    k_c, v_c = _to_chunks(k), _to_chunks(v)
    li, lf = _to_chunks(log_i), _to_chunks(log_f)
    b = jnp.cumsum(lf, axis=-1)
    b_last = b[..., -1]
    a = b_last[..., None] - b + li
    g = jnp.max(a, axis=-1)
    w = jnp.exp(a - g[..., None])
    kv = jnp.einsum("bhcs,bhcsd,bhcse->bhcde", w, k_c, v_c)
    kn = jnp.einsum("bhcs,bhcsd->bhcd", w, k_c)

    def step(carry, xs):
        c_st, n_st, m_st = carry
        bl, gj, kvj, knj = xs
        m_new = jnp.maximum(bl + m_st, gj)
        decay = jnp.exp(bl + m_st - m_new)
        inject = jnp.exp(gj - m_new)
        c_new = decay[..., None, None] * c_st + inject[..., None, None] * kvj
        n_new = decay[..., None] * n_st + inject[..., None] * knj
        return (c_new, n_new, m_new), (c_st, n_st, m_st)

    xs = (jnp.moveaxis(b_last, 2, 0), jnp.moveaxis(g, 2, 0), jnp.moveaxis(kv, 2, 0), jnp.moveaxis(kn, 2, 0))
    final, starts = lax.scan(step, state, xs)
    if not need_out:
        return None, final
    c0 = jnp.moveaxis(starts[0], 0, 2)
    n0 = jnp.moveaxis(starts[1], 0, 2)
    m0 = jnp.moveaxis(starts[2], 0, 2)
    q_c = _to_chunks(q)
    L = q_c.shape[-2]
    d = b[..., :, None] - b[..., None, :] + li[..., None, :]
    d = jnp.where(jnp.tril(jnp.ones((L, L), dtype=bool)), d, -jnp.inf)
    inter = b + m0[..., None]
    m_t = jnp.maximum(jnp.max(d, axis=-1), inter)
    wq = jnp.exp(d - m_t[..., None]) * jnp.einsum("bhctd,bhcsd->bhcts", q_c, k_c)
    carry_w = jnp.exp(inter - m_t)
    num = jnp.einsum("bhcts,bhcse->bhcte", wq, v_c) + carry_w[..., None] * jnp.einsum("bhctd,bhcde->bhcte", q_c, c0)
    den = jnp.sum(wq, axis=-1) + carry_w * jnp.einsum("bhctd,bhcd->bhct", q_c, n0)
    h = num / jnp.maximum(jnp.abs(den), jnp.exp(-m_t))[..., None]
    return _from_chunks(h), final


def _mlstm_mixer(u_ctx, u_lat, w_in, gate_b, head_norm, w_out, need_ctx):
    qk = A_HEADS * A_DQK
    vd = A_HEADS * A_DV
    splits = [qk, 2 * qk, 2 * qk + vd, 2 * qk + vd + D_MODEL]

    def project(u):
        bsz, n = u.shape[:2]
        q, k, v, o, gates = jnp.split(u @ w_in, splits, axis=-1)
        q = q.astype(F32).reshape(bsz, n, A_HEADS, A_DQK)
        k = k.astype(F32).reshape(bsz, n, A_HEADS, A_DQK) * (A_DQK ** -0.5)
        v = v.astype(F32).reshape(bsz, n, A_HEADS, A_DV)
        gates = gates.astype(F32).reshape(bsz, n, 4, A_HEADS) + gate_b.astype(F32)
        fwd = (gates[:, :, 0], jax.nn.log_sigmoid(gates[:, :, 1]))
        bwd = (gates[:, :, 2], jax.nn.log_sigmoid(gates[:, :, 3]))
        return q, k, v, o, fwd, bwd

    def flip(t):
        return jnp.flip(t, axis=1)

    cq, ck, cv, co, cf, cb = project(u_ctx)
    lq, lk, lv, lo, lf, lb = project(u_lat)
    bsz = u_lat.shape[0]
    zero = (jnp.zeros((bsz, A_HEADS, A_DQK, A_DV), F32), jnp.zeros((bsz, A_HEADS, A_DQK), F32),
            jnp.zeros((bsz, A_HEADS), F32))
    hcf, st_f = _mlstm_direction(cq, ck, cv, cf[0], cf[1], zero, need_ctx)
    hcb, st_b = _mlstm_direction(flip(cq), flip(ck), flip(cv), flip(cb[0]), flip(cb[1]), zero, need_ctx)
    hlf, _ = _mlstm_direction(lq, lk, lv, lf[0], lf[1], st_f, True)
    hlb, _ = _mlstm_direction(flip(lq), flip(lk), flip(lv), flip(lb[0]), flip(lb[1]), st_b, True)

    def finish(hf, hb, o):
        hs = hf + flip(hb)
        hn = hs * lax.rsqrt(jnp.mean(hs * hs, axis=-1, keepdims=True) + NORM_EPS)
        hn = hn * head_norm.astype(F32).reshape(A_HEADS, A_DV)
        bsz_, n = hs.shape[:2]
        return (hn.reshape(bsz_, n, vd).astype(o.dtype) * jax.nn.sigmoid(o)) @ w_out

    y_lat = finish(hlf, hlb, lo)
    y_ctx = finish(hcf, hcb, co) if need_ctx else None
    return y_lat, y_ctx


def _swa_mixer(u_ctx, u_lat, w_in, sink, w_out, cos, sin, need_ctx):
    scale = SWA_DH ** -0.5
    sink_g = sink.astype(F32).reshape(SWA_KV_HEADS, SWA_GROUP)[:, :, None]

    def project(u):
        bsz, n = u.shape[:2]
        q, k, v = jnp.split(u @ w_in, [SWA_HEADS * SWA_DH, (SWA_HEADS + SWA_KV_HEADS) * SWA_DH], axis=-1)
        return (q.reshape(bsz, n, SWA_HEADS, SWA_DH), k.reshape(bsz, n, SWA_KV_HEADS, SWA_DH),
                v.reshape(bsz, n, SWA_KV_HEADS, SWA_DH))

    cq, ck, cv = project(u_ctx)
    lq, lk, lv = project(u_lat)
    lq = _apply_rope(lq, cos, sin)
    lk = _apply_rope(lk, cos, sin)
    bsz, n_tok = u_lat.shape[:2]
    nb = n_tok // SWA_BLOCK
    kp = jnp.pad(lk, ((0, 0), (SWA_BLOCK, SWA_BLOCK), (0, 0), (0, 0)))
    vp = jnp.pad(lv, ((0, 0), (SWA_BLOCK, SWA_BLOCK), (0, 0), (0, 0)))
    q_blocks = jnp.moveaxis(lq.reshape(bsz, nb, SWA_BLOCK, SWA_KV_HEADS, SWA_GROUP, SWA_DH), 1, 0)
    q_idx = jnp.arange(SWA_BLOCK)[:, None]
    k_idx = jnp.arange(3 * SWA_BLOCK)[None, :]
    rel = k_idx - SWA_BLOCK - q_idx

    def block(args):
        j, qb = args
        kb = lax.dynamic_slice_in_dim(kp, j * SWA_BLOCK, 3 * SWA_BLOCK, axis=1)
        vb = lax.dynamic_slice_in_dim(vp, j * SWA_BLOCK, 3 * SWA_BLOCK, axis=1)
        kpos = j * SWA_BLOCK - SWA_BLOCK + k_idx
        valid = (jnp.abs(rel) <= WINDOW) & (kpos >= 0) & (kpos < n_tok)
        s_lat = jnp.einsum("bqhgd,bkhd->bhgqk", qb, kb).astype(F32) * scale
        s_lat = jnp.where(valid, s_lat, -jnp.inf)
        s_ctx = jnp.einsum("bqhgd,bchd->bhgqc", qb, ck).astype(F32) * scale
        m = jnp.maximum(jnp.maximum(jnp.max(s_lat, -1), jnp.max(s_ctx, -1)), sink_g)
        p_lat = jnp.exp(s_lat - m[..., None])
        p_ctx = jnp.exp(s_ctx - m[..., None])
        den = jnp.sum(p_lat, -1) + jnp.sum(p_ctx, -1) + jnp.exp(sink_g - m)
        o = jnp.einsum("bhgqk,bkhd->bqhgd", p_lat, vb) + jnp.einsum("bhgqc,bchd->bqhgd", p_ctx, cv)
        return o / jnp.moveaxis(den, 3, 1)[..., None]

    o_lat = lax.map(block, (jnp.arange(nb), q_blocks))
    o_lat = jnp.moveaxis(o_lat, 0, 1).reshape(bsz, n_tok, SWA_HEADS * SWA_DH)
    y_lat = o_lat.astype(u_lat.dtype) @ w_out
    if not need_ctx:
        return y_lat, None
    n_ctx = u_ctx.shape[1]
    cqg = cq.reshape(bsz, n_ctx, SWA_KV_HEADS, SWA_GROUP, SWA_DH)
    s = jnp.einsum("bqhgd,bchd->bhgqc", cqg, ck).astype(F32) * scale
    m = jnp.maximum(jnp.max(s, -1), sink_g)
    p = jnp.exp(s - m[..., None])
    den = jnp.sum(p, -1) + jnp.exp(sink_g - m)
    o_ctx = jnp.einsum("bhgqc,bchd->bqhgd", p, cv) / jnp.moveaxis(den, 3, 1)[..., None]
    y_ctx = o_ctx.reshape(bsz, n_ctx, SWA_HEADS * SWA_DH).astype(u_ctx.dtype) @ w_out
    return y_lat, y_ctx


def _diff_mixer(u_ctx, u_lat, w_in, lam_q1, lam_k1, lam_q2, lam_k2, head_norm, w_out, cos, sin,
                layer_idx, need_ctx):
    scale = DIFF_DH ** -0.5
    lam_init = 0.8 - 0.6 * math.exp(-0.3 * layer_idx)
    lam = (jnp.exp(jnp.sum(lam_q1.astype(F32) * lam_k1.astype(F32)))
           - jnp.exp(jnp.sum(lam_q2.astype(F32) * lam_k2.astype(F32))) + lam_init)
    qk = 2 * DIFF_HEADS * DIFF_DH

    def project(u, rope):
        bsz, n = u.shape[:2]
        q, k, v = jnp.split(u @ w_in, [qk, 2 * qk], axis=-1)
        q = q.reshape(bsz, n, 2 * DIFF_HEADS, DIFF_DH)
        k = k.reshape(bsz, n, 2 * DIFF_HEADS, DIFF_DH)
        if rope:
            q = _apply_rope(q, cos, sin)
            k = _apply_rope(k, cos, sin)
        return (q.reshape(bsz, n, DIFF_HEADS, 2, DIFF_DH), k.reshape(bsz, n, DIFF_HEADS, 2, DIFF_DH),
                v.reshape(bsz, n, DIFF_HEADS, DIFF_DV))

    def finish(o, dtype):
        od = o[:, :, :, 0] - lam * o[:, :, :, 1]
        od = od * lax.rsqrt(jnp.mean(od * od, axis=-1, keepdims=True) + NORM_EPS)
        od = od * head_norm.astype(F32).reshape(DIFF_HEADS, DIFF_DV) * (1.0 - lam_init)
        bsz, n = od.shape[:2]
        return od.reshape(bsz, n, DIFF_HEADS * DIFF_DV).astype(dtype) @ w_out

    cq, ck, cv = project(u_ctx, False)
    lq, lk, lv = project(u_lat, True)
    bsz, n_tok = u_lat.shape[:2]
    nb = n_tok // DIFF_BLOCK
    q_blocks = jnp.moveaxis(lq.reshape(bsz, nb, DIFF_BLOCK, DIFF_HEADS, 2, DIFF_DH), 1, 0)

    def block(qb):
        s_lat = jnp.einsum("bqhmd,bkhmd->bhmqk", qb, lk).astype(F32) * scale
        s_ctx = jnp.einsum("bqhmd,bchmd->bhmqc", qb, ck).astype(F32) * scale
        mx = jnp.maximum(jnp.max(s_lat, -1), jnp.max(s_ctx, -1))[..., None]
        p_lat = jnp.exp(s_lat - mx)
        p_ctx = jnp.exp(s_ctx - mx)
        den = jnp.sum(p_lat, -1) + jnp.sum(p_ctx, -1)
        o = jnp.einsum("bhmqk,bkhe->bqhme", p_lat, lv) + jnp.einsum("bhmqc,bche->bqhme", p_ctx, cv)
        return o / jnp.moveaxis(den, 3, 1)[..., None]

    o_lat = lax.map(block, q_blocks)
    o_lat = jnp.moveaxis(o_lat, 0, 1).reshape(bsz, n_tok, DIFF_HEADS, 2, DIFF_DV)
    y_lat = finish(o_lat, u_lat.dtype)
    if not need_ctx:
        return y_lat, None
    s = jnp.einsum("bqhmd,bkhmd->bhmqk", cq, ck).astype(F32) * scale
    a = jax.nn.softmax(s, axis=-1)
    o_ctx = jnp.einsum("bhmqk,bkhe->bqhme", a, cv)
    return y_lat, finish(o_ctx, u_ctx.dtype)


def setup_inputs(seed: int = 0) -> dict:
    key = jax.random.key(seed)
    ks = jax.random.split(key, 25)
    D = D_MODEL

    def nrm(k, shape, scale):
        return jax.random.normal(k, shape, F32) * scale

    forget_bias = jnp.linspace(3.0, 6.0, A_HEADS, dtype=F32)
    zeros_h = jnp.zeros((A_HEADS,), F32)
    gate_base = jnp.stack([zeros_h, forget_bias, zeros_h, forget_bias])
    return {
        "x": nrm(ks[0], (BATCH, SEQ, D), 1.0),
        "c": nrm(ks[1], (BATCH, D), 1.0),
        "ctx": nrm(ks[2], (BATCH, CTX_LEN, D), 1.0),
        "c_ctx": nrm(ks[3], (D,), 1.0),
        "ada_w": nrm(ks[4], (DEPTH, D, 6 * D), 0.5 * D ** -0.5),
        "ada_b": nrm(ks[5], (DEPTH, 6 * D), 0.02),
        "norm_mix": 1.0 + nrm(ks[6], (DEPTH, D), 0.02),
        "norm_ffn": 1.0 + nrm(ks[7], (DEPTH, D), 0.02),
        "ffn_w1": nrm(ks[8], (DEPTH, D, D_FF), D ** -0.5),
        "ffn_w2": nrm(ks[9], (DEPTH, D_FF, D), D_FF ** -0.5),
        "mlstm_w_in": nrm(ks[10], (N_MLSTM, D, A_IN), D ** -0.5),
        "mlstm_gate_b": gate_base + nrm(ks[11], (N_MLSTM, 4, A_HEADS), 0.1),
        "mlstm_head_norm": 1.0 + nrm(ks[12], (N_MLSTM, A_HEADS * A_DV), 0.02),
        "mlstm_w_out": nrm(ks[13], (N_MLSTM, A_HEADS * A_DV, D), (A_HEADS * A_DV) ** -0.5),
        "swa_w_in": nrm(ks[14], (N_SWA, D, SWA_IN), D ** -0.5),
        "swa_sink": nrm(ks[15], (N_SWA, SWA_HEADS), 0.5),
        "swa_w_out": nrm(ks[16], (N_SWA, SWA_HEADS * SWA_DH, D), (SWA_HEADS * SWA_DH) ** -0.5),
        "diff_w_in": nrm(ks[17], (N_DIFF, D, DIFF_IN), D ** -0.5),
        "diff_lambda_q1": nrm(ks[18], (N_DIFF, DIFF_DH), 0.1),
        "diff_lambda_k1": nrm(ks[19], (N_DIFF, DIFF_DH), 0.1),
        "diff_lambda_q2": nrm(ks[20], (N_DIFF, DIFF_DH), 0.1),
        "diff_lambda_k2": nrm(ks[21], (N_DIFF, DIFF_DH), 0.1),
        "diff_head_norm": 1.0 + nrm(ks[22], (N_DIFF, DIFF_HEADS * DIFF_DV), 0.02),
        "diff_w_out": nrm(ks[23], (N_DIFF, DIFF_HEADS * DIFF_DV, D), (DIFF_HEADS * DIFF_DV) ** -0.5),
        "final_norm": 1.0 + nrm(ks[24], (D,), 0.02),
    }


def reference(x, c, ctx, c_ctx, ada_w, ada_b, norm_mix, norm_ffn, ffn_w1, ffn_w2,
              mlstm_w_in, mlstm_gate_b, mlstm_head_norm, mlstm_w_out,
              swa_w_in, swa_sink, swa_w_out,
              diff_w_in, diff_lambda_q1, diff_lambda_k1, diff_lambda_q2, diff_lambda_k2,
              diff_head_norm, diff_w_out, final_norm):
    n_tok = x.shape[1]
    cos_s, sin_s = _axial_rope_tables(n_tok, SWA_DH)
    cos_d, sin_d = _axial_rope_tables(n_tok, DIFF_DH)
    cond_lat = jax.nn.silu(c)[:, None, :]
    cond_ctx = jax.nn.silu(c_ctx)[None, None, :]
    h, hc = x, ctx
    for i in range(DEPTH):
        kind, slot = i % N_MIXERS, i // N_MIXERS
        need_ctx = i < DEPTH - 1
        mod_l = jnp.split(cond_lat @ ada_w[i] + ada_b[i], 6, axis=-1)
        mod_c = jnp.split(cond_ctx @ ada_w[i] + ada_b[i], 6, axis=-1)
        u = _modulate(_rms_norm(h, norm_mix[i]), mod_l[0], mod_l[1])
        uc = _modulate(_rms_norm(hc, norm_mix[i]), mod_c[0], mod_c[1])
        if kind == 0:
            y, yc = _mlstm_mixer(uc, u, mlstm_w_in[slot], mlstm_gate_b[slot], mlstm_head_norm[slot],
                                 mlstm_w_out[slot], need_ctx)
        elif kind == 1:
            y, yc = _swa_mixer(uc, u, swa_w_in[slot], swa_sink[slot], swa_w_out[slot], cos_s, sin_s, need_ctx)
        else:
            y, yc = _diff_mixer(uc, u, diff_w_in[slot], diff_lambda_q1[slot], diff_lambda_k1[slot],
                                diff_lambda_q2[slot], diff_lambda_k2[slot], diff_head_norm[slot],
                                diff_w_out[slot], cos_d, sin_d, i, need_ctx)
        h = h + mod_l[2] * y
        h = h + mod_l[5] * _sq_relu_mlp(_modulate(_rms_norm(h, norm_ffn[i]), mod_l[3], mod_l[4]),
                                        ffn_w1[i], ffn_w2[i])
        if need_ctx:
            hc = hc + mod_c[2] * yc
            hc = hc + mod_c[5] * _sq_relu_mlp(_modulate(_rms_norm(hc, norm_ffn[i]), mod_c[3], mod_c[4]),
                                              ffn_w1[i], ffn_w2[i])
    return _rms_norm(h, final_norm)
```

```cpp
#include <hip/hip_runtime.h>
#include <hip/hip_cooperative_groups.h>
#include <cstdio>
#include <cstdint>
namespace cg = cooperative_groups;
namespace pg8 {
#define PG8_LAS __attribute__((address_space(3)))
typedef unsigned short bf16_t;
typedef short bf16x8 __attribute__((ext_vector_type(8)));
typedef float f32x4 __attribute__((ext_vector_type(4)));
typedef unsigned u32x4 __attribute__((ext_vector_type(4)));
constexpr int BM = 256, BK = 64, HALF = 128, HTB = HALF * BK * 2  , STAGE_BYTES = 8 * HTB, NXCD = 8, WGM = 8;

__host__ __device__ __forceinline__ int lds_byte(int r, int c) { const int st = (r >> 4) * 2 + (c >> 5), rr = r & 15, cc = c & 31, ob = rr * 64 + cc * 2; return st * 1024 + (ob ^ (((ob >> 9) & 1) << 5)); }
__host__ __device__ __forceinline__ void stage_rc(int b, int& R, int& C) { const int st = b / 1024, sb = b % 1024, swz = sb ^ (((sb >> 9) & 1) << 5); R = (st >> 1) * 16 + swz / 64; C = (st & 1) * 32 + (swz % 64) / 2; }
__host__ __device__ __forceinline__ int perm32(int rho) { const int n = rho >> 4, i = rho & 15; return 8 * (i >> 2) + 4 * n + (i & 3); }

struct Unit { int pm, pn; };
struct Gemm { const bf16_t* A; const bf16_t* Bt; int M, N, K; };

struct StaticOrder {
    int nM, nN, nwg, G, c;
    __host__ __device__ void init(int M, int N, int G_, int c_) { nM = M / BM; nN = N / BM; nwg = nM * nN; G = G_; c = c_; }
    __host__ __device__ bool next(int i, Unit& u) const {
        const long L = (long)i * G + c; if (L >= nwg) return false;
        int wgid = (int)L; { const int q = nwg / NXCD, r = nwg % NXCD, xcd = wgid % NXCD, off = wgid / NXCD; wgid = (xcd < r ? xcd * (q + 1) : r * (q + 1) + (xcd - r) * q) + off; }
        const int nig = WGM * nN, gid = wgid / nig, fm = gid * WGM, gsz = (nM - fm) < WGM ? (nM - fm) : WGM;
        u.pm = fm + ((wgid % nig) % gsz); u.pn = (wgid % nig) / gsz; return true;
    }
    __device__ __forceinline__ void a_ready(const Unit&) const {}
    __device__ __forceinline__ void done(const Unit&) const {}
};

__device__ __forceinline__ unsigned cvt_pk_bf16(float lo, float hi) { unsigned r; asm volatile("v_cvt_pk_bf16_f32 %0, %1, %2" : "=v"(r) : "v"(lo), "v"(hi)); return r; }
template <class Epi, class Sched, bool ALIGN_EPI = false, bool SP2 = false>
__device__ __forceinline__ void gemm_phase(PG8_LAS unsigned char* lds, const Gemm g, const Sched& S, const Epi& E) {
    int tid_o = threadIdx.x; asm volatile("" : "+v"(tid_o)); const int tid = tid_o, wid = __builtin_amdgcn_readfirstlane(tid >> 6), lane = tid & 63, wr = wid >> 2, wc = wid & 3, fr = lane & 15, fq = lane >> 4;
    const int K = g.K, nt = K / BK;
    unsigned voffA[2], voffB[2];
#pragma unroll
    for (int i = 0; i < 2; ++i) { int R, C; stage_rc(tid * 16 + i * 8192, R, C); const int Rb = Epi::PERM ? ((R & ~31) + perm32(R & 31)) : R;
        voffA[i] = (unsigned)(R * K + C) * 2u; voffB[i] = (unsigned)(Rb * K + C) * 2u; }
    const size_t kstep = (size_t)(BK * 2);
    const size_t hstep = (size_t)HALF * K * 2;
    const size_t tstep = 2 * hstep;
    const unsigned ldsw = (unsigned)wid * 1024u;
    const int aoff = lds_byte(wr * 64 + fr, fq * 8), boff = lds_byte(wc * 32 + fr, fq * 8);
#define PG8_SA(b, h) (((b) * 2 + (h)) * HTB)
#define PG8_SB(b, h) ((4 + (b) * 2 + (h)) * HTB)
#define PG8_STAGE(bufoff, gbase, voff) do { _Pragma("unroll") for (int _i = 0; _i < 2; ++_i) \
        __builtin_amdgcn_global_load_lds((const unsigned*)((const char*)(gbase) + (voff)[_i]), (PG8_LAS unsigned*)(lds + (bufoff) + ldsw + _i * 8192), 16, 0, 0); } while (0)
#define PG8_LDA(dst, b, h) do { _Pragma("unroll") for (int m = 0; m < 4; ++m) _Pragma("unroll") for (int k = 0; k < 2; ++k) dst[m][k] = *(const PG8_LAS bf16x8*)(lds + PG8_SA(b, h) + aoff + m * 2048 + k * 1024); } while (0)
#define PG8_LDB(dst, b, h) do { _Pragma("unroll") for (int n = 0; n < 2; ++n) _Pragma("unroll") for (int k = 0; k < 2; ++k) dst[n][k] = *(const PG8_LAS bf16x8*)(lds + PG8_SB(b, h) + boff + n * 2048 + k * 1024); } while (0)
#define PG8_MMA(ai, bj, At, Bt) do { __builtin_amdgcn_s_setprio(1); _Pragma("unroll") for (int m = 0; m < 4; ++m) _Pragma("unroll") for (int n = 0; n < 2; ++n) _Pragma("unroll") for (int k = 0; k < 2; ++k) \
        acc[ai][bj][m][n] = __builtin_amdgcn_mfma_f32_16x16x32_bf16(Bt[n][k], At[m][k], acc[ai][bj][m][n], 0, 0, 0); __builtin_amdgcn_s_setprio(0); } while (0)
#define PG8_WAIT_V(n) asm volatile("s_waitcnt vmcnt(" #n ")" ::: "memory")
#define PG8_WAIT_L(n) asm volatile("s_waitcnt lgkmcnt(" #n ")" ::: "memory")
#define PG8_BAR __builtin_amdgcn_s_barrier()
#define PG8_SCHED __builtin_amdgcn_sched_barrier(0)
    Unit cur, nxt; int ui = 0;
    if (!S.next(0, cur)) return;
    f32x4 acc[2][2][4][2];
#pragma unroll
    for (int a = 0; a < 2; ++a)
#pragma unroll
        for (int b = 0; b < 2; ++b)
#pragma unroll
            for (int m = 0; m < 4; ++m)
#pragma unroll
                for (int n = 0; n < 2; ++n) acc[a][b][m][n] = (f32x4){0.f, 0.f, 0.f, 0.f};
    bf16x8 At[4][2], B0[2][2], B1[2][2];
    const char* cA = (const char*)g.A + (size_t)cur.pm * tstep; const char* cB = (const char*)g.Bt + (size_t)cur.pn * tstep;
    S.a_ready(cur);
    if constexpr (SP2) {
        PG8_STAGE(PG8_SB(0, 0), cB, voffB); PG8_STAGE(PG8_SB(0, 1), cB + hstep, voffB); PG8_STAGE(PG8_SA(0, 0), cA, voffA); PG8_STAGE(PG8_SA(0, 1), cA + hstep, voffA);
        if (wr == 1) PG8_BAR;
        PG8_WAIT_V(2); PG8_BAR;
        PG8_STAGE(PG8_SB(1, 0), cB + kstep, voffB); PG8_STAGE(PG8_SA(1, 0), cA + kstep, voffA); PG8_STAGE(PG8_SB(1, 1), cB + hstep + kstep, voffB);
        PG8_WAIT_V(6); PG8_BAR;
    } else {
        PG8_STAGE(PG8_SB(0, 0), cB, voffB); PG8_STAGE(PG8_SA(0, 0), cA, voffA); PG8_STAGE(PG8_SB(0, 1), cB + hstep, voffB); PG8_STAGE(PG8_SA(0, 1), cA + hstep, voffA);
        if (wr == 1) PG8_BAR;
        PG8_WAIT_V(4); PG8_BAR;
        PG8_STAGE(PG8_SB(1, 0), cB + kstep, voffB); PG8_STAGE(PG8_SA(1, 0), cA + kstep, voffA); PG8_STAGE(PG8_SB(1, 1), cB + hstep + kstep, voffB);
        PG8_WAIT_V(6); PG8_BAR;
    }
    for (;;) {
        const bool has_next = S.next(ui + 1, nxt);
        const char* nA = has_next ? (const char*)g.A + (size_t)nxt.pm * tstep : cA; const char* nB = has_next ? (const char*)g.Bt + (size_t)nxt.pn * tstep : cB;
        for (int t = 0; t < nt; t += 2) {
            const bool last = (t == nt - 2);
            const char* a1 = cA + (size_t)(t + 1) * kstep;
            const char* a2 = last ? nA : cA + (size_t)(t + 2) * kstep; const char* b2 = last ? nB : cB + (size_t)(t + 2) * kstep;
            const char* a3 = a2 + kstep; const char* b3 = b2 + kstep;
            if (last && has_next) S.a_ready(nxt);
            if constexpr (SP2) {
            PG8_LDB(B0, 0, 0); PG8_LDB(B1, 0, 1); PG8_SCHED; PG8_LDA(At, 0, 0); PG8_STAGE(PG8_SA(1, 1), a1 + hstep, voffA);
            PG8_WAIT_V(8); PG8_WAIT_L(0); PG8_BAR; PG8_MMA(0, 0, At, B0); PG8_MMA(0, 1, At, B1); PG8_BAR; PG8_SCHED;
            PG8_LDA(At, 0, 1); PG8_STAGE(PG8_SB(0, 0), b2, voffB); PG8_STAGE(PG8_SB(0, 1), b2 + hstep, voffB); PG8_STAGE(PG8_SA(0, 0), a2, voffA);
            PG8_WAIT_V(8); PG8_WAIT_L(0); PG8_BAR; PG8_MMA(1, 0, At, B0); PG8_MMA(1, 1, At, B1); PG8_BAR; PG8_SCHED;
            PG8_LDB(B0, 1, 0); PG8_LDB(B1, 1, 1); PG8_SCHED; PG8_LDA(At, 1, 0); PG8_STAGE(PG8_SA(0, 1), a2 + hstep, voffA);
            PG8_WAIT_V(8); PG8_WAIT_L(0); PG8_BAR; PG8_MMA(0, 0, At, B0); PG8_MMA(0, 1, At, B1); PG8_BAR; PG8_SCHED;
            PG8_LDA(At, 1, 1); PG8_STAGE(PG8_SB(1, 0), b3, voffB); PG8_STAGE(PG8_SB(1, 1), b3 + hstep, voffB); PG8_STAGE(PG8_SA(1, 0), a3, voffA);
            PG8_WAIT_V(8); PG8_WAIT_L(0); PG8_BAR; PG8_MMA(1, 0, At, B0); PG8_MMA(1, 1, At, B1); PG8_BAR; PG8_SCHED;
            } else {
            PG8_LDB(B0, 0, 0); PG8_SCHED; PG8_LDA(At, 0, 0); PG8_STAGE(PG8_SA(1, 1), a1 + hstep, voffA);
            PG8_WAIT_L(8); PG8_BAR; PG8_WAIT_L(0); PG8_MMA(0, 0, At, B0); PG8_BAR; PG8_SCHED;
            PG8_LDB(B1, 0, 1); PG8_STAGE(PG8_SB(0, 0), b2, voffB);
            PG8_BAR; PG8_WAIT_L(0); PG8_MMA(0, 1, At, B1); PG8_BAR;
            PG8_LDA(At, 0, 1); PG8_STAGE(PG8_SA(0, 0), a2, voffA);
            PG8_BAR; PG8_WAIT_L(0); PG8_MMA(1, 0, At, B0); PG8_BAR; PG8_SCHED;
            PG8_STAGE(PG8_SB(0, 1), b2 + hstep, voffB);
            PG8_WAIT_V(6); PG8_BAR; PG8_MMA(1, 1, At, B1); PG8_BAR;
            PG8_LDB(B0, 1, 0); PG8_SCHED; PG8_LDA(At, 1, 0); PG8_STAGE(PG8_SA(0, 1), a2 + hstep, voffA);
            PG8_WAIT_L(8); PG8_BAR; PG8_WAIT_L(0); PG8_MMA(0, 0, At, B0); PG8_BAR; PG8_SCHED;
            PG8_LDB(B1, 1, 1); PG8_STAGE(PG8_SB(1, 0), b3, voffB);
            PG8_BAR; PG8_WAIT_L(0); PG8_MMA(0, 1, At, B1); PG8_BAR;
            PG8_LDA(At, 1, 1); PG8_STAGE(PG8_SA(1, 0), a3, voffA);
            PG8_BAR; PG8_WAIT_L(0); PG8_MMA(1, 0, At, B0); PG8_BAR; PG8_SCHED;
            PG8_STAGE(PG8_SB(1, 1), b3 + hstep, voffB);
            PG8_WAIT_V(6); PG8_BAR; PG8_MMA(1, 1, At, B1); PG8_BAR;
            }
        }
        if constexpr (ALIGN_EPI) { if (wr == 0) PG8_BAR; }
        if constexpr (!Epi::AFTER_DRAIN) { E(acc, cur, wr, wc, fr, fq); S.done(cur); }
        if (!has_next) break;
#pragma unroll
        for (int a = 0; a < 2; ++a)
#pragma unroll
            for (int b = 0; b < 2; ++b)
#pragma unroll
                for (int m = 0; m < 4; ++m)
#pragma unroll
                    for (int n = 0; n < 2; ++n) acc[a][b][m][n] = (f32x4){0.f, 0.f, 0.f, 0.f};
        cur = nxt; cA = nA; cB = nB; ++ui;
        if constexpr (ALIGN_EPI) { if (wr == 1) PG8_BAR; }
    }
    PG8_WAIT_V(0);
    if constexpr (!ALIGN_EPI) { if (wr == 0) PG8_BAR; }
    PG8_BAR;
    if constexpr (Epi::AFTER_DRAIN) { E.fused(acc, cur, wr, wc, fr, fq, lds, wid, lane); S.done(cur); }
#undef PG8_SA
#undef PG8_SB
#undef PG8_STAGE
#undef PG8_LDA
#undef PG8_LDB
#undef PG8_MMA
#undef PG8_WAIT_V
#undef PG8_WAIT_L
#undef PG8_BAR
#undef PG8_SCHED
}
}
using pg8::bf16_t; using pg8::bf16x8; using pg8::f32x4; using pg8::u32x4;
#define LAS __attribute__((address_space(3)))
#define DI __device__ __forceinline__
typedef short s16x4 __attribute__((ext_vector_type(4)));
typedef short v4i16_t __attribute__((ext_vector_type(4)));
typedef float f32x16 __attribute__((ext_vector_type(16)));
typedef float f32x2_t __attribute__((ext_vector_type(2)));
typedef __bf16 bf16x2_t __attribute__((ext_vector_type(2)));
typedef unsigned u32x2 __attribute__((ext_vector_type(2)));
#define MFMA32(a, b, c) __builtin_amdgcn_mfma_f32_32x32x16_bf16((a), (b), (c), 0, 0, 0)

constexpr int DM = 1024, NB = 8, SEQ = 2048, CTX = 256, DEPTH = 4, DFF = 4096;
constexpr int MLAT = NB * SEQ, MCTX = NB * CTX, MTOT = MLAT + MCTX;
constexpr int NIN_A = 3328, NIN_B = 1536, NIN_C = 3072;
constexpr float EPS = 1e-6f;
constexpr size_t MiB = 1u << 20;
constexpr size_t WS_MODS = 0, WS_ROPE = 1 * MiB, WS_HC = 2 * MiB, WS_WIN = 10 * MiB, WS_WOUT = 17 * MiB, WS_W1 = 19 * MiB, WS_W2 = 27 * MiB,
                 WS_ABUF = 36 * MiB, WS_BIG = 72 * MiB, WS_HF = 216 * MiB, WS_HB = 252 * MiB, WS_END = 288 * MiB;
constexpr int LDS_BYTES = 147456;
constexpr int NTHREADS = 512;

struct Params { const float* in[25]; float* out; unsigned char* ws; int ph_lo, ph_hi; };

DI unsigned pk2(float lo, float hi) { f32x2_t v = {lo, hi}; bf16x2_t b = __builtin_convertvector(v, bf16x2_t); return __builtin_bit_cast(unsigned, b); }
DI float bflo(unsigned u) { return __uint_as_float(u << 16); }
DI float bfhi(unsigned u) { return __uint_as_float(u & 0xffff0000u); }
DI float bf1(unsigned short u) { return __uint_as_float(((unsigned)u) << 16); }
DI float wave_sum(float v) {
#pragma unroll
    for (int o = 1; o < 64; o <<= 1) v += __shfl_xor(v, o);
    return v;
}
DI int crow(int i, int h) { return (i & 3) + 8 * (i >> 2) + 4 * h; }
DI s16x4 vtr(const LAS char* p) { return __builtin_bit_cast(s16x4, __builtin_amdgcn_ds_read_tr16_b64_v4i16((LAS v4i16_t*)p)); }
DI bf16x8 cat8(s16x4 lo, s16x4 hi) { return __builtin_shufflevector(lo, hi, 0, 1, 2, 3, 4, 5, 6, 7); }
template <int S> DI bf16x8 packP(const f32x16& x) {
    u32x4 p; p.x = pk2(x[8 * S + 0], x[8 * S + 1]); p.y = pk2(x[8 * S + 2], x[8 * S + 3]); p.z = pk2(x[8 * S + 4], x[8 * S + 5]); p.w = pk2(x[8 * S + 6], x[8 * S + 7]);
    return __builtin_bit_cast(bf16x8, p);
}
#define LDS_WAIT() asm volatile("s_waitcnt lgkmcnt(0)" ::: "memory")

struct EpiQKV {
    static constexpr bool PERM = true, AFTER_DRAIN = false;
    bf16_t* O; int ldc; int rope_cols; const float* rope;
    DI void operator()(const f32x4 (&acc)[2][2][4][2], const pg8::Unit& u, int wr, int wc, int fr, int fq) const {
        const int row0 = u.pm * 256 + wr * 64 + fr, col0 = u.pn * 256 + wc * 32 + 8 * fq;
        const bool do_rope = (u.pn * 256 < rope_cols) && (u.pm < 64);
#pragma unroll
        for (int ai = 0; ai < 2; ++ai)
#pragma unroll
            for (int m = 0; m < 4; ++m) {
                const int row = row0 + ai * 128 + m * 16; bf16_t* rowp = O + (size_t)row * ldc + col0; const int t = row & 2047;
#pragma unroll
                for (int bj = 0; bj < 2; ++bj) {
                    f32x4 v0 = acc[ai][bj][m][0], v1 = acc[ai][bj][m][1];
                    if (do_rope) {
                        const int j0 = ((col0 + bj * 128) & 63) >> 1;
                        const f32x4 cs0 = *(const f32x4*)(rope + (size_t)(t * 32 + j0) * 2), cs1 = *(const f32x4*)(rope + (size_t)(t * 32 + j0) * 2 + 4);
                        f32x4 r0, r1;
                        r0[0] = v0[0] * cs0[0] - v0[1] * cs0[1]; r0[1] = v0[0] * cs0[1] + v0[1] * cs0[0];
                        r0[2] = v0[2] * cs0[2] - v0[3] * cs0[3]; r0[3] = v0[2] * cs0[3] + v0[3] * cs0[2];
                        r1[0] = v1[0] * cs1[0] - v1[1] * cs1[1]; r1[1] = v1[0] * cs1[1] + v1[1] * cs1[0];
                        r1[2] = v1[2] * cs1[2] - v1[3] * cs1[3]; r1[3] = v1[2] * cs1[3] + v1[3] * cs1[2];
                        v0 = r0; v1 = r1;
                    }
                    u32x4 w; w.x = pk2(v0[0], v0[1]); w.y = pk2(v0[2], v0[3]); w.z = pk2(v1[0], v1[1]); w.w = pk2(v1[2], v1[3]);
                    *(u32x4*)(rowp + bj * 128) = w;
                }
            }
    }
};
struct EpiSqRelu {
    static constexpr bool PERM = true, AFTER_DRAIN = false;
    bf16_t* O; int ldc;
    DI void operator()(const f32x4 (&acc)[2][2][4][2], const pg8::Unit& u, int wr, int wc, int fr, int fq) const {
        const int row0 = u.pm * 256 + wr * 64 + fr, col0 = u.pn * 256 + wc * 32 + 8 * fq;
#pragma unroll
        for (int ai = 0; ai < 2; ++ai)
#pragma unroll
            for (int m = 0; m < 4; ++m) {
                bf16_t* rowp = O + (size_t)(row0 + ai * 128 + m * 16) * ldc + col0;
#pragma unroll
                for (int bj = 0; bj < 2; ++bj) {
                    f32x4 v0 = acc[ai][bj][m][0], v1 = acc[ai][bj][m][1];
#pragma unroll
                    for (int e = 0; e < 4; ++e) { float a = fmaxf(v0[e], 0.f), b = fmaxf(v1[e], 0.f); v0[e] = a * a; v1[e] = b * b; }
                    u32x4 w; w.x = pk2(v0[0], v0[1]); w.y = pk2(v0[2], v0[3]); w.z = pk2(v1[0], v1[1]); w.w = pk2(v1[2], v1[3]);
                    *(u32x4*)(rowp + bj * 128) = w;
                }
            }
    }
};
struct EpiResid {
    static constexpr bool PERM = true, AFTER_DRAIN = false;
    float* hlat; float* hctx; const float* gate_base;
    DI void operator()(const f32x4 (&acc)[2][2][4][2], const pg8::Unit& u, int wr, int wc, int fr, int fq) const {
        const int idx = u.pm < 64 ? (u.pm >> 3) : 8;
        float* hb = u.pm < 64 ? hlat + (size_t)u.pm * 256 * DM : hctx + (size_t)(u.pm - 64) * 256 * DM;
        const int col0 = u.pn * 256 + wc * 32 + 8 * fq;
        const float* gp = gate_base + idx * 6144 + col0;
        float* rowp0 = hb + (size_t)(wr * 64 + fr) * DM + col0;
#pragma unroll
        for (int bj = 0; bj < 2; ++bj)
#pragma unroll
            for (int n = 0; n < 2; ++n) {
                const f32x4 g = *(const f32x4*)(gp + bj * 128 + 4 * n);
#pragma unroll
                for (int ai = 0; ai < 2; ++ai)
#pragma unroll
                    for (int m = 0; m < 4; ++m) {
                        float* p = rowp0 + (size_t)(ai * 128 + m * 16) * DM + bj * 128 + 4 * n;
                        f32x4 h0 = *(f32x4*)p; h0 = h0 + g * acc[ai][bj][m][n]; *(f32x4*)p = h0;
                    }
            }
    }
};

DI void norm_row(const float* hrow, const float* g, const float* shift, const float* scale, bf16_t* orow, int lane) {
    const f32x4* xr = (const f32x4*)hrow + lane;
    f32x4 v[4]; float s = 0.f;
#pragma unroll
    for (int j = 0; j < 4; ++j) { v[j] = xr[64 * j]; s += (v[j][0] * v[j][0] + v[j][1] * v[j][1]) + (v[j][2] * v[j][2] + v[j][3] * v[j][3]); }
    const float rstd = 1.f / sqrtf(wave_sum(s) * (1.f / DM) + EPS);
    u32x2* o8 = (u32x2*)orow + lane;
#pragma unroll
    for (int j = 0; j < 4; ++j) {
        const f32x4 gg = ((const f32x4*)g)[lane + 64 * j];
        f32x4 y = v[j] * rstd * gg;
        if (shift) { const f32x4 sh = ((const f32x4*)shift)[lane + 64 * j], sc = ((const f32x4*)scale)[lane + 64 * j]; y = y * (sc + 1.f) + sh; }
        u32x2 w; w.x = pk2(y[0], y[1]); w.y = pk2(y[2], y[3]); o8[64 * j] = w;
    }
}
struct ConvDesc { const float* W; bf16_t* WT; int K, Nsrc, Ndst, rope_cols, sc_lo, sc_hi; };
DI void conv_item(const ConvDesc& d, LAS float* scr, int item, int lane) {
    const int nblk = d.Ndst / 32, kb = item / nblk, nb = item % nblk, k0 = 64 * kb, n0 = 32 * nb;
    const int q = lane & 31, nd = n0 + q;
    int ns = nd;
    if (nd < d.rope_cols) { const int head = nd >> 6, p = nd & 63; ns = head * 64 + (p >> 1) + 32 * (p & 1); }
    const bool valid = ns < d.Nsrc;
    const float scl = (nd >= d.sc_lo && nd < d.sc_hi) ? 0.125f : 1.f;
    const float* src = d.W + (size_t)k0 * d.Nsrc + (valid ? ns : 0);
#pragma unroll 8
    for (int i = 0; i < 32; ++i) { const int kk = 2 * i + (lane >> 5); const float w = src[(size_t)kk * d.Nsrc]; scr[kk * 33 + q] = valid ? w * scl : 0.f; }
    LDS_WAIT();
    const int c = lane & 7;
#pragma unroll
    for (int j = 0; j < 4; ++j) {
        const int n = (lane >> 3) + 8 * j; const LAS float* s = scr + (8 * c) * 33 + n;
        u32x4 o; o.x = pk2(s[0 * 33], s[1 * 33]); o.y = pk2(s[2 * 33], s[3 * 33]); o.z = pk2(s[4 * 33], s[5 * 33]); o.w = pk2(s[6 * 33], s[7 * 33]);
        *(u32x4*)(d.WT + (size_t)(n0 + n) * d.K + k0 + 8 * c) = o;
    }
    LDS_WAIT();
}
DI void swa_phase(LAS char* lds, const bf16_t* QKV, bf16_t* Obuf, const float* sink, bool need_ctx) {
    int tid_ = threadIdx.x; asm volatile("" : "+v"(tid_)); const int tid = tid_, lane = tid & 63, w = __builtin_amdgcn_readfirstlane(tid >> 6), r = lane & 31, h = lane >> 5;
    const int g = w >> 1, th = w & 1;
    const int i16 = lane & 15, q4 = i16 >> 2, p4 = i16 & 3, g1 = (lane >> 4) & 1;
    LAS char* Kimg = lds; LAS char* Vimg = lds + 9216;
    const int srow = tid >> 3, piece = tid & 7;
    const int nunits = 1024 + (need_ctx ? 128 : 0);
    for (int u = blockIdx.x; u < nunits; u += gridDim.x) {
        int b, kvh, qrow0, t0 = 0, c_lo = 0, n_lat = 0;
        if (u < 1024) { b = u >> 7; kvh = (u >> 5) & 3; t0 = (u & 31) * 64; qrow0 = b * SEQ + t0;
            c_lo = t0 == 0 ? 2 : (t0 == 64 ? 1 : 0); int c_hi = (2176 - t0) / 64; if (c_hi > 5) c_hi = 5; n_lat = c_hi - c_lo; }
        else { const int v = u - 1024; b = v >> 4; kvh = (v >> 2) & 3; qrow0 = MLAT + b * CTX + (v & 3) * 64; }
        const int n = n_lat + 4;
        const int qrow = qrow0 + 32 * th + r, hq = kvh * 4 + g;
        bf16x8 qf[4];
#pragma unroll
        for (int s = 0; s < 4; ++s) qf[s] = *(const bf16x8*)(QKV + (size_t)qrow * NIN_B + hq * 64 + 16 * s + 8 * h);
        float m = sink[hq], l = (h == 0) ? 1.f : 0.f;
        f32x16 O[2];
#pragma unroll
        for (int i = 0; i < 16; ++i) { O[0][i] = 0.f; O[1][i] = 0.f; }
        u32x4 kreg, vreg;
        { const int base = (0 < n_lat) ? b * SEQ + t0 - 128 + 64 * c_lo : MLAT + b * CTX;
          const bf16_t* gp = QKV + (size_t)(base + srow) * NIN_B + kvh * 64 + piece * 8; kreg = *(const u32x4*)(gp + 1024); vreg = *(const u32x4*)(gp + 1280); }
        for (int i = 0; i < n; ++i) {
            __syncthreads();
            *(LAS u32x4*)(Kimg + srow * 144 + piece * 16) = kreg; *(LAS u32x4*)(Vimg + srow * 144 + piece * 16) = vreg;
            __syncthreads();
            if (i + 1 < n) { const int ii = i + 1; const int base = (ii < n_lat) ? b * SEQ + t0 - 128 + 64 * (c_lo + ii) : MLAT + b * CTX + 64 * (ii - n_lat);
                const bf16_t* gp = QKV + (size_t)(base + srow) * NIN_B + kvh * 64 + piece * 8; kreg = *(const u32x4*)(gp + 1024); vreg = *(const u32x4*)(gp + 1280); }
            const bool masked = i < n_lat; const int kpos0 = t0 - 128 + 64 * (c_lo + i), qp = t0 + 32 * th + r;
#pragma unroll
            for (int tile = 0; tile < 2; ++tile) {
                f32x16 S;
#pragma unroll
                for (int e = 0; e < 16; ++e) S[e] = 0.f;
#pragma unroll
                for (int s = 0; s < 4; ++s) { const bf16x8 kf = *(const LAS bf16x8*)(Kimg + (32 * tile + r) * 144 + (16 * s + 8 * h) * 2); S = MFMA32(kf, qf[s], S); }
                if (masked) {
#pragma unroll
                    for (int e = 0; e < 16; ++e) { const int d = kpos0 + 32 * tile + crow(e, h) - qp; if (d > 128 || d < -128) S[e] = -INFINITY; }
                }
                float tmax = S[0];
#pragma unroll
                for (int e = 1; e < 16; ++e) tmax = fmaxf(tmax, S[e]);
                tmax = fmaxf(tmax, __shfl_xor(tmax, 32));
                const float mn = fmaxf(m, tmax), alpha = __expf(m - mn); m = mn;
                float ls = 0.f;
#pragma unroll
                for (int e = 0; e < 16; ++e) { S[e] = __expf(S[e] - mn); ls += S[e]; }
                l = l * alpha + ls;
#pragma unroll
                for (int e = 0; e < 16; ++e) { O[0][e] *= alpha; O[1][e] *= alpha; }
                const bf16x8 pf0 = packP<0>(S), pf1 = packP<1>(S);
#pragma unroll
                for (int blk = 0; blk < 2; ++blk) {
                    const LAS char* vp = Vimg + (32 * tile + 4 * h + q4) * 144 + 2 * (32 * blk + 16 * g1) + 8 * p4;
                    const bf16x8 vf0 = cat8(vtr(vp), vtr(vp + 8 * 144)), vf1 = cat8(vtr(vp + 16 * 144), vtr(vp + 24 * 144));
                    O[blk] = MFMA32(vf0, pf0, O[blk]); O[blk] = MFMA32(vf1, pf1, O[blk]);
                }
            }
        }
        const float inv = 1.f / (l + __shfl_xor(l, 32));
        bf16_t* orow = Obuf + (size_t)qrow * DM + hq * 64 + 4 * h;
#pragma unroll
        for (int blk = 0; blk < 2; ++blk)
#pragma unroll
            for (int ig = 0; ig < 4; ++ig) { u32x2 o; o.x = pk2(O[blk][4 * ig] * inv, O[blk][4 * ig + 1] * inv); o.y = pk2(O[blk][4 * ig + 2] * inv, O[blk][4 * ig + 3] * inv);
                *(u32x2*)(orow + 32 * blk + 8 * ig) = o; }
    }
    __syncthreads();
}

DI void diff_phase(LAS char* lds, const bf16_t* QKV, bf16_t* Obuf, const float* hnorm, float lam, float one_m_lam_init, bool need_ctx) {
    int tid_ = threadIdx.x; asm volatile("" : "+v"(tid_)); const int tid = tid_, lane = tid & 63, w = __builtin_amdgcn_readfirstlane(tid >> 6), r = lane & 31, h = lane >> 5;
    const int mp = w >> 2, tb = w & 3;
    const int i16 = lane & 15, q4 = i16 >> 2, p4 = i16 & 3, g1 = (lane >> 4) & 1;
    LAS char* Kimg = lds; LAS char* Vimg = lds + 17408;
    LAS float* X = (LAS float*)(lds + 34816);
    const int srow = tid >> 3, piece = tid & 7;
    const int nunits = 1024 + (need_ctx ? 128 : 0);
    for (int u = blockIdx.x; u < nunits; u += gridDim.x) {
        int b, hh, qrow0, n_lat;
        if (u < 1024) { b = u >> 7; hh = (u >> 4) & 7; qrow0 = b * SEQ + (u & 15) * 128; n_lat = 32; }
        else { const int v = u - 1024; b = v >> 4; hh = (v >> 1) & 7; qrow0 = MLAT + b * CTX + (v & 1) * 128; n_lat = 0; }
        const int n = n_lat + 4;
        const int qrow = qrow0 + 32 * tb + r;
        bf16x8 qf[4];
#pragma unroll
        for (int s = 0; s < 4; ++s) qf[s] = *(const bf16x8*)(QKV + (size_t)qrow * NIN_C + (hh * 2 + mp) * 64 + 16 * s + 8 * h);
        float m = -INFINITY, l = 0.f;
        f32x16 O[4];
#pragma unroll
        for (int bk = 0; bk < 4; ++bk)
#pragma unroll
            for (int i = 0; i < 16; ++i) O[bk][i] = 0.f;
        u32x4 kreg[2], vreg[2];
        { const int base = (0 < n_lat) ? b * SEQ : MLAT + b * CTX;
          const bf16_t* gp = QKV + (size_t)(base + srow) * NIN_C + hh * 128 + piece * 8;
          kreg[0] = *(const u32x4*)(gp + 1024); kreg[1] = *(const u32x4*)(gp + 1024 + 64); vreg[0] = *(const u32x4*)(gp + 2048); vreg[1] = *(const u32x4*)(gp + 2048 + 64); }
        for (int i = 0; i < n; ++i) {
            __syncthreads();
            *(LAS u32x4*)(Kimg + srow * 272 + piece * 16) = kreg[0]; *(LAS u32x4*)(Kimg + srow * 272 + 128 + piece * 16) = kreg[1];
            *(LAS u32x4*)(Vimg + srow * 272 + piece * 16) = vreg[0]; *(LAS u32x4*)(Vimg + srow * 272 + 128 + piece * 16) = vreg[1];
            __syncthreads();
            if (i + 1 < n) { const int ii = i + 1; const int base = (ii < n_lat) ? b * SEQ + 64 * ii : MLAT + b * CTX + 64 * (ii - n_lat);
                const bf16_t* gp = QKV + (size_t)(base + srow) * NIN_C + hh * 128 + piece * 8;
                kreg[0] = *(const u32x4*)(gp + 1024); kreg[1] = *(const u32x4*)(gp + 1024 + 64); vreg[0] = *(const u32x4*)(gp + 2048); vreg[1] = *(const u32x4*)(gp + 2048 + 64); }
#pragma unroll
            for (int tile = 0; tile < 2; ++tile) {
                f32x16 S;
#pragma unroll
                for (int e = 0; e < 16; ++e) S[e] = 0.f;
#pragma unroll
                for (int s = 0; s < 4; ++s) { const bf16x8 kf = *(const LAS bf16x8*)(Kimg + (32 * tile + r) * 272 + mp * 128 + (16 * s + 8 * h) * 2); S = MFMA32(kf, qf[s], S); }
                float tmax = S[0];
#pragma unroll
                for (int e = 1; e < 16; ++e) tmax = fmaxf(tmax, S[e]);
                tmax = fmaxf(tmax, __shfl_xor(tmax, 32));
                const float mn = fmaxf(m, tmax), alpha = __expf(m - mn); m = mn;
                float ls = 0.f;
#pragma unroll
                for (int e = 0; e < 16; ++e) { S[e] = __expf(S[e] - mn); ls += S[e]; }
                l = l * alpha + ls;
#pragma unroll
                for (int bk = 0; bk < 4; ++bk)
#pragma unroll
                    for (int e = 0; e < 16; ++e) O[bk][e] *= alpha;
                const bf16x8 pf0 = packP<0>(S), pf1 = packP<1>(S);
#pragma unroll
                for (int blk = 0; blk < 4; ++blk) {
                    const LAS char* vp = Vimg + (32 * tile + 4 * h + q4) * 272 + 2 * (32 * blk + 16 * g1) + 8 * p4;
                    const bf16x8 vf0 = cat8(vtr(vp), vtr(vp + 8 * 272)), vf1 = cat8(vtr(vp + 16 * 272), vtr(vp + 24 * 272));
                    O[blk] = MFMA32(vf0, pf0, O[blk]); O[blk] = MFMA32(vf1, pf1, O[blk]);
                }
            }
        }
        const float inv = 1.f / (l + __shfl_xor(l, 32));
        if (mp == 1) {
#pragma unroll
            for (int blk = 0; blk < 4; ++blk)
#pragma unroll
                for (int e = 0; e < 16; ++e) X[(tb * 128 + 32 * blk + crow(e, h)) * 32 + r] = O[blk][e] * inv;
        }
        __syncthreads();
        if (mp == 0) {
            float ss = 0.f;
#pragma unroll
            for (int blk = 0; blk < 4; ++blk)
#pragma unroll
                for (int e = 0; e < 16; ++e) { const float od = O[blk][e] * inv - lam * X[(tb * 128 + 32 * blk + crow(e, h)) * 32 + r]; O[blk][e] = od; ss += od * od; }
            ss += __shfl_xor(ss, 32);
            const float rstd = one_m_lam_init / sqrtf(ss * (1.f / 128.f) + EPS);
            bf16_t* orow = Obuf + (size_t)qrow * DM + hh * 128 + 4 * h; const float* hn = hnorm + hh * 128 + 4 * h;
#pragma unroll
            for (int blk = 0; blk < 4; ++blk)
#pragma unroll
                for (int ig = 0; ig < 4; ++ig) { const f32x4 gn = *(const f32x4*)(hn + 32 * blk + 8 * ig);
                    u32x2 o; o.x = pk2(O[blk][4 * ig] * rstd * gn[0], O[blk][4 * ig + 1] * rstd * gn[1]); o.y = pk2(O[blk][4 * ig + 2] * rstd * gn[2], O[blk][4 * ig + 3] * rstd * gn[3]);
                    *(u32x2*)(orow + 32 * blk + 8 * ig) = o; }
        }
    }
    __syncthreads();
}
DI void mlstm_scan(LAS char* lds, const bf16_t* QKV, const float* gate_b, bf16_t* HF, bf16_t* HB, bool need_ctx) {
    int tid_ = threadIdx.x; asm volatile("" : "+v"(tid_)); const int tid = tid_, lane = tid & 63, w = __builtin_amdgcn_readfirstlane(tid >> 6), r = lane & 31, h = lane >> 5;
    const int tb = w & 3, dvh = w >> 2, dvb = w & 3, db = w >> 2;
    const int i16 = lane & 15, q4 = i16 >> 2, p4 = i16 & 3, g1 = (lane >> 4) & 1;
    LAS char* Qimg = lds;
    LAS char* Kimg = lds + 18432;
    LAS char* Vimg = lds + 36864;
    LAS char* Cimg = lds + 71680;
    LAS float* bvec = (LAS float*)(lds + 89088);
    LAS float* evec = bvec + 128;
    LAS float* cvec = bvec + 256;
    LAS float* n0 = bvec + 384;
    LAS float* npart = bvec + 448;
    LAS float* scal = bvec + 960;
    for (int it = blockIdx.x; it < 128; it += gridDim.x) {
        const int b = it >> 4, hh = (it >> 1) & 7, dir = it & 1;
        const float gb_i = gate_b[(2 * dir) * 8 + hh], gb_f = gate_b[(2 * dir + 1) * 8 + hh];
        bf16_t* HO = dir ? HB : HF;
        f32x16 Cacc;
#pragma unroll
        for (int e = 0; e < 16; ++e) Cacc[e] = 0.f;
        const int srow = tid >> 2, pc = tid & 3;
        u32x4 qreg[2], kreg[2], vreg[4]; float raw_i = 0.f, raw_f = 0.f;
#define ML_BASE(ci) ((ci) < 2 ? MLAT + b * CTX + 128 * (dir ? 1 - (ci) : (ci)) : b * SEQ + 128 * (dir ? 15 - ((ci) - 2) : ((ci) - 2)))
#define ML_LOAD(ci) do { const int base_ = ML_BASE(ci); const int grow_ = dir ? base_ + 127 - srow : base_ + srow; \
            const bf16_t* gp_ = QKV + (size_t)grow_ * NIN_A + hh * 64 + pc * 8; \
            qreg[0] = *(const u32x4*)(gp_); qreg[1] = *(const u32x4*)(gp_ + 32); kreg[0] = *(const u32x4*)(gp_ + 512); kreg[1] = *(const u32x4*)(gp_ + 512 + 32); \
            const bf16_t* gv_ = QKV + (size_t)grow_ * NIN_A + 1024 + hh * 128 + pc * 8; \
            vreg[0] = *(const u32x4*)(gv_); vreg[1] = *(const u32x4*)(gv_ + 32); vreg[2] = *(const u32x4*)(gv_ + 64); vreg[3] = *(const u32x4*)(gv_ + 96); \
            if (tid < 128) { const int gr2_ = dir ? base_ + 127 - tid : base_ + tid; const bf16_t* gg_ = QKV + (size_t)gr2_ * NIN_A + 3072 + (2 * dir) * 8 + hh; raw_i = bf1(gg_[0]); raw_f = bf1(gg_[8]); } } while (0)
        ML_LOAD(0);
        __syncthreads();
        for (int ci = 0; ci < 18; ++ci) {
            *(LAS u32x4*)(Qimg + srow * 144 + pc * 16) = qreg[0]; *(LAS u32x4*)(Qimg + srow * 144 + 64 + pc * 16) = qreg[1];
            *(LAS u32x4*)(Kimg + srow * 144 + pc * 16) = kreg[0]; *(LAS u32x4*)(Kimg + srow * 144 + 64 + pc * 16) = kreg[1];
#pragma unroll
            for (int k = 0; k < 4; ++k) *(LAS u32x4*)(Vimg + srow * 272 + 64 * k + pc * 16) = vreg[k];
            if (tid < 128) { const float xf = raw_f + gb_f; evec[tid] = raw_i + gb_i; bvec[tid] = fminf(xf, 0.f) - log1pf(__expf(-fabsf(xf))); }
#pragma unroll
            for (int ig = 0; ig < 4; ++ig) { u32x2 o; o.x = pk2(Cacc[4 * ig], Cacc[4 * ig + 1]); o.y = pk2(Cacc[4 * ig + 2], Cacc[4 * ig + 3]);
                *(LAS u32x2*)(Cimg + (32 * db + r) * 272 + 2 * (32 * dvb + 8 * ig + 4 * h)) = o; }
            if (tid < 64) { float nn = 0.f; if (ci > 0) { const float dec = __expf(scal[0] - scal[1]); nn = dec * n0[tid];
#pragma unroll
                    for (int p = 0; p < 8; ++p) nn += npart[p * 64 + tid]; }
                n0[tid] = nn; }
            __syncthreads();
            if (w == 0) {
                const float m0 = (ci > 0) ? scal[2] + scal[1] : 0.f;
                const float lf0 = bvec[2 * lane], lf1 = bvec[2 * lane + 1], li0 = evec[2 * lane], li1 = evec[2 * lane + 1];
                const float s2 = lf0 + lf1; float inc = s2;
#pragma unroll
                for (int o = 1; o < 64; o <<= 1) { const float v = __shfl_up(inc, o); if (lane >= o) inc += v; }
                const float b0 = inc - s2 + lf0, b1 = inc;
                const float e0 = li0 - b0, e1 = li1 - b1;
                float mx = fmaxf(e0, e1);
#pragma unroll
                for (int o = 1; o < 64; o <<= 1) { const float v = __shfl_up(mx, o); if (lane >= o) mx = fmaxf(mx, v); }
                float ex = __shfl_up(mx, 1); if (lane == 0) ex = -INFINITY;
                const float M0 = fmaxf(ex, e0), M1 = mx;
                LDS_WAIT();
                bvec[2 * lane] = b0; bvec[2 * lane + 1] = b1; evec[2 * lane] = e0; evec[2 * lane + 1] = e1;
                cvec[2 * lane] = fmaxf(M0, m0); cvec[2 * lane + 1] = fmaxf(M1, m0);
                if (lane == 63) { scal[0] = m0; scal[1] = fmaxf(M1, m0); scal[2] = b1; }
            }
            __syncthreads();
            if (ci + 1 < 18) ML_LOAD(ci + 1);
            const float m0 = scal[0], c127 = scal[1];
            {
                const int t = 32 * tb + r;
                const float c_t = cvec[t], b_t = bvec[t], cw = __expf(m0 - c_t);
                bf16x8 qf[4];
#pragma unroll
                for (int ks = 0; ks < 4; ++ks) qf[ks] = *(const LAS bf16x8*)(Qimg + t * 144 + (16 * ks + 8 * h) * 2);
                f32x16 acc[2];
#pragma unroll
                for (int e = 0; e < 16; ++e) { acc[0][e] = 0.f; acc[1][e] = 0.f; }
                float dn = 0.f;
#pragma unroll
                for (int ks = 0; ks < 4; ++ks) {
#pragma unroll
                    for (int blk = 0; blk < 2; ++blk) {
                        const LAS char* cp = Cimg + (16 * ks + 8 * h + q4) * 272 + 2 * (64 * dvh + 32 * blk + 16 * g1) + 8 * p4;
                        const bf16x8 cf = cat8(vtr(cp), vtr(cp + 4 * 272));
                        acc[blk] = MFMA32(cf, qf[ks], acc[blk]);
                    }
                    const u32x4 qu = __builtin_bit_cast(u32x4, qf[ks]); const LAS float* np = n0 + 16 * ks + 8 * h;
                    dn += bflo(qu.x) * np[0] + bfhi(qu.x) * np[1] + bflo(qu.y) * np[2] + bfhi(qu.y) * np[3] + bflo(qu.z) * np[4] + bfhi(qu.z) * np[5] + bflo(qu.w) * np[6] + bfhi(qu.w) * np[7];
                }
                dn += __shfl_xor(dn, 32);
#pragma unroll
                for (int e = 0; e < 16; ++e) { acc[0][e] *= cw; acc[1][e] *= cw; }
                float dsum = 0.f;
                for (int st = 0; st <= tb; ++st) {
                    f32x16 S;
#pragma unroll
                    for (int e = 0; e < 16; ++e) S[e] = 0.f;
#pragma unroll
                    for (int ks = 0; ks < 4; ++ks) { const bf16x8 kf = *(const LAS bf16x8*)(Kimg + (32 * st + r) * 144 + (16 * ks + 8 * h) * 2); S = MFMA32(kf, qf[ks], S); }
#pragma unroll
                    for (int e = 0; e < 16; ++e) { const int s = 32 * st + crow(e, h); const float wgt = (s <= t) ? __expf(evec[s] - c_t) : 0.f; S[e] *= wgt; dsum += S[e]; }
                    const bf16x8 pf0 = packP<0>(S), pf1 = packP<1>(S);
#pragma unroll
                    for (int blk = 0; blk < 2; ++blk) {
                        const LAS char* vp = Vimg + (32 * st + 4 * h + q4) * 272 + 2 * (64 * dvh + 32 * blk + 16 * g1) + 8 * p4;
                        const bf16x8 vf0 = cat8(vtr(vp), vtr(vp + 8 * 272)), vf1 = cat8(vtr(vp + 16 * 272), vtr(vp + 24 * 272));
                        acc[blk] = MFMA32(vf0, pf0, acc[blk]); acc[blk] = MFMA32(vf1, pf1, acc[blk]);
                    }
                }
                dsum += __shfl_xor(dsum, 32);
                const float den = dsum + cw * dn;
                const float inv = 1.f / fmaxf(fabsf(den), __expf(-(b_t + c_t)));
                if (ci >= 2 || need_ctx) {
                    const int base = ML_BASE(ci); const int orow_i = dir ? base + 127 - t : base + t;
                    bf16_t* orow = HO + (size_t)orow_i * DM + hh * 128 + 64 * dvh + 4 * h;
#pragma unroll
                    for (int blk = 0; blk < 2; ++blk)
#pragma unroll
                        for (int ig = 0; ig < 4; ++ig) { u32x2 o; o.x = pk2(acc[blk][4 * ig] * inv, acc[blk][4 * ig + 1] * inv); o.y = pk2(acc[blk][4 * ig + 2] * inv, acc[blk][4 * ig + 3] * inv);
                            *(u32x2*)(orow + 32 * blk + 8 * ig) = o; }
                }
            }
            {
                const float dec = __expf(m0 - c127);
#pragma unroll
                for (int e = 0; e < 16; ++e) Cacc[e] *= dec;
#pragma unroll
                for (int ks = 0; ks < 8; ++ks) {
                    const LAS char* vp = Vimg + (16 * ks + 8 * h + q4) * 272 + 2 * (32 * dvb + 16 * g1) + 8 * p4;
                    const bf16x8 vf = cat8(vtr(vp), vtr(vp + 4 * 272));
                    const LAS char* kp = Kimg + (16 * ks + 8 * h + q4) * 144 + 2 * (32 * db + 16 * g1) + 8 * p4;
                    const s16x4 klo = vtr(kp), khi = vtr(kp + 4 * 144);
                    const LAS float* ep = evec + 16 * ks + 8 * h;
                    float kw[8];
#pragma unroll
                    for (int j = 0; j < 4; ++j) { kw[j] = bf1((unsigned short)klo[j]) * __expf(ep[j] - c127); kw[4 + j] = bf1((unsigned short)khi[j]) * __expf(ep[4 + j] - c127); }
                    u32x4 kk; kk.x = pk2(kw[0], kw[1]); kk.y = pk2(kw[2], kw[3]); kk.z = pk2(kw[4], kw[5]); kk.w = pk2(kw[6], kw[7]);
                    Cacc = MFMA32(vf, __builtin_bit_cast(bf16x8, kk), Cacc);
                }
                const int d = tid & 63; float np_ = 0.f;
#pragma unroll
                for (int s = 0; s < 16; ++s) { const int ss = 16 * w + s; np_ += __expf(evec[ss] - c127) * bf1(*(const LAS unsigned short*)(Kimg + ss * 144 + 2 * d)); }
                npart[w * 64 + d] = np_;
            }
            __syncthreads();
        }
#undef ML_LOAD
#undef ML_BASE
    }
    __syncthreads();
}

DI void mlstm_finish_row(const bf16_t* HF, const bf16_t* HB, const bf16_t* QKV, const float* hnorm, bf16_t* Obuf, int row, int lane) {
    const int c0 = 16 * lane;
    const u32x4 f0 = *(const u32x4*)(HF + (size_t)row * DM + c0), f1 = *(const u32x4*)(HF + (size_t)row * DM + c0 + 8);
    const u32x4 b0 = *(const u32x4*)(HB + (size_t)row * DM + c0), b1 = *(const u32x4*)(HB + (size_t)row * DM + c0 + 8);
    const u32x4 o0 = *(const u32x4*)(QKV + (size_t)row * NIN_A + 2048 + c0), o1 = *(const u32x4*)(QKV + (size_t)row * NIN_A + 2048 + c0 + 8);
    float hs[16], og[16];
#pragma unroll
    for (int k = 0; k < 4; ++k) { hs[2 * k] = bflo(f0[k]) + bflo(b0[k]); hs[2 * k + 1] = bfhi(f0[k]) + bfhi(b0[k]); hs[8 + 2 * k] = bflo(f1[k]) + bflo(b1[k]); hs[8 + 2 * k + 1] = bfhi(f1[k]) + bfhi(b1[k]);
        og[2 * k] = bflo(o0[k]); og[2 * k + 1] = bfhi(o0[k]); og[8 + 2 * k] = bflo(o1[k]); og[8 + 2 * k + 1] = bfhi(o1[k]); }
    float ss = 0.f;
#pragma unroll
    for (int k = 0; k < 16; ++k) ss += hs[k] * hs[k];
    ss += __shfl_xor(ss, 1); ss += __shfl_xor(ss, 2); ss += __shfl_xor(ss, 4);
    const float rstd = 1.f / sqrtf(ss * (1.f / 128.f) + EPS);
    float y[16];
#pragma unroll
    for (int k = 0; k < 16; ++k) y[k] = hs[k] * rstd * hnorm[c0 + k] * (1.f / (1.f + __expf(-og[k])));
    u32x4 w0, w1; w0.x = pk2(y[0], y[1]); w0.y = pk2(y[2], y[3]); w0.z = pk2(y[4], y[5]); w0.w = pk2(y[6], y[7]);
    w1.x = pk2(y[8], y[9]); w1.y = pk2(y[10], y[11]); w1.z = pk2(y[12], y[13]); w1.w = pk2(y[14], y[15]);
    *(u32x4*)(Obuf + (size_t)row * DM + c0) = w0; *(u32x4*)(Obuf + (size_t)row * DM + c0 + 8) = w1;
}
DI void p0_phase(const Params& P, LAS char* lds) {
    int tid_ = threadIdx.x; asm volatile("" : "+v"(tid_)); const int tid = tid_;
    float* mods = (float*)(P.ws + WS_MODS); float* rope = (float*)(P.ws + WS_ROPE); float* hc = (float*)(P.ws + WS_HC);
    const float* c = P.in[1]; const float* cctx = P.in[3]; const float* ada_w = P.in[4]; const float* ada_b = P.in[5];
    { const size_t gt = (size_t)blockIdx.x * NTHREADS + tid, gs = (size_t)gridDim.x * NTHREADS;
      const f32x4* xs = (const f32x4*)P.in[0]; f32x4* xd = (f32x4*)P.out;
      for (size_t i = gt; i < (size_t)MLAT * DM / 4; i += gs) xd[i] = xs[i];
      const f32x4* cs = (const f32x4*)P.in[2]; f32x4* cd = (f32x4*)hc;
      for (size_t i = gt; i < (size_t)MCTX * DM / 4; i += gs) cd[i] = cs[i];
      for (size_t i = gt; i < (size_t)SEQ * 32; i += gs) { const int t = (int)(i >> 5), j = (int)(i & 31);
          const float pos = (float)((j < 16) ? (t >> 6) : (t & 63)); const float inv = powf(10000.0f, -(float)(j & 15) / 16.0f); const float ang = pos * inv;
          rope[2 * i] = cosf(ang); rope[2 * i + 1] = sinf(ang); } }
    LAS float* sc = (LAS float*)lds;
    LAS float* part = sc + 9 * 1024;
    for (int i = tid; i < 9 * 1024; i += NTHREADS) { const int idx = i >> 10, k = i & 1023; const float v = idx < 8 ? c[idx * 1024 + k] : cctx[k]; sc[i] = v / (1.f + expf(-v)); }
    __syncthreads();
    for (int item = blockIdx.x; item < 4 * 48; item += gridDim.x) {
        const int l = item / 48, cb = item % 48, col = tid & 127, kq = tid >> 7;
        const float* W = ada_w + (size_t)l * 1024 * 6144 + cb * 128 + col;
        float acc[9];
#pragma unroll
        for (int i = 0; i < 9; ++i) acc[i] = 0.f;
#pragma unroll 8
        for (int k = kq * 256; k < kq * 256 + 256; ++k) { const float wv = W[(size_t)k * 6144];
#pragma unroll
            for (int i = 0; i < 9; ++i) acc[i] += sc[i * 1024 + k] * wv; }
#pragma unroll
        for (int i = 0; i < 9; ++i) part[(kq * 9 + i) * 128 + col] = acc[i];
        __syncthreads();
        for (int o = tid; o < 9 * 128; o += NTHREADS) { const int i = o >> 7, cc = o & 127;
            const float s = (part[(0 * 9 + i) * 128 + cc] + part[(1 * 9 + i) * 128 + cc]) + (part[(2 * 9 + i) * 128 + cc] + part[(3 * 9 + i) * 128 + cc]) + ada_b[l * 6144 + cb * 128 + cc];
            mods[(size_t)(l * 9 + i) * 6144 + cb * 128 + cc] = s; }
        __syncthreads();
    }
}

__global__ void __launch_bounds__(NTHREADS, 2) mega(Params P) {
    extern __shared__ __attribute__((aligned(16))) unsigned char lds_raw[];
    LAS char* lds = (LAS char*)lds_raw;
    cg::grid_group grid = cg::this_grid();
#define THIN_IDS int tid_ = threadIdx.x; asm volatile("" : "+v"(tid_)); const int lane = tid_ & 63, wave = __builtin_amdgcn_readfirstlane(tid_ >> 6); const int gw = blockIdx.x * 8 + wave, NGW = gridDim.x * 8;
    const int lo = P.ph_lo, hi = P.ph_hi;
    int ph = 0;
#define RUN(k) ((k) >= lo && (k) < hi)
#define SEAM(k) do { if ((k) >= lo && (k) + 1 < hi) grid.sync(); } while (0)
    unsigned char* ws = P.ws;
    float* mods = (float*)(ws + WS_MODS); const float* rope = (const float*)(ws + WS_ROPE); float* hc = (float*)(ws + WS_HC);
    bf16_t* Win = (bf16_t*)(ws + WS_WIN); bf16_t* Wout = (bf16_t*)(ws + WS_WOUT); bf16_t* W1 = (bf16_t*)(ws + WS_W1); bf16_t* W2 = (bf16_t*)(ws + WS_W2);
    bf16_t* Abuf = (bf16_t*)(ws + WS_ABUF); bf16_t* BIG = (bf16_t*)(ws + WS_BIG); bf16_t* HF = (bf16_t*)(ws + WS_HF); bf16_t* HB = (bf16_t*)(ws + WS_HB);
    float* hlat = P.out;

    #ifndef DIS_P0
    if (RUN(ph)) p0_phase(P, lds);
#endif
    SEAM(ph); ++ph;

#pragma unroll 1
    for (int l = 0; l < DEPTH; ++l) {
        const int kind = l % 3, slot = l / 3;
        const bool need_ctx = l < DEPTH - 1;
        const int Mrows = need_ctx ? MTOT : MLAT;
        const int Nin = kind == 0 ? NIN_A : (kind == 1 ? NIN_B : NIN_C);
        const float* modl = mods + (size_t)l * 9 * 6144;
        if (RUN(ph)) {
            THIN_IDS
            LAS float* scr = (LAS float*)(lds + wave * 16384);
            ConvDesc cin, cout, c1, c2;
            if (kind == 0) cin = ConvDesc{P.in[10] + (size_t)slot * 1024 * 3104, Win, 1024, 3104, NIN_A, 0, 512, 1024};
            else if (kind == 1) cin = ConvDesc{P.in[14], Win, 1024, 1536, NIN_B, 1280, 0, 1024};
            else cin = ConvDesc{P.in[17], Win, 1024, 3072, NIN_C, 2048, 0, 1024};
            const float* wo = kind == 0 ? P.in[13] + (size_t)slot * 1024 * 1024 : (kind == 1 ? P.in[16] : P.in[23]);
            cout = ConvDesc{wo, Wout, 1024, 1024, 1024, 0, 0, 0};
            c1 = ConvDesc{P.in[8] + (size_t)l * 1024 * 4096, W1, 1024, 4096, 4096, 0, 0, 0};
            c2 = ConvDesc{P.in[9] + (size_t)l * 4096 * 1024, W2, 4096, 1024, 1024, 0, 0, 0};
            const int n_in = 16 * (Nin / 32), n_out = 16 * 32, n_1 = 16 * 128, n_2 = 64 * 32;
            for (int it = gw; it < n_in + n_out + n_1 + n_2; it += NGW) {
                int rr = it;
                if (rr < n_in) { conv_item(cin, scr, rr, lane); continue; } rr -= n_in;
                if (rr < n_out) { conv_item(cout, scr, rr, lane); continue; } rr -= n_out;
                if (rr < n_1) { conv_item(c1, scr, rr, lane); continue; } rr -= n_1;
                conv_item(c2, scr, rr, lane);
            }
            const float* gn = P.in[6] + l * DM;
            for (int row = gw; row < MTOT; row += NGW) {
                const int idx = row < MLAT ? (row >> 11) : 8;
                const float* hrow = row < MLAT ? hlat + (size_t)row * DM : hc + (size_t)(row - MLAT) * DM;
                norm_row(hrow, gn, modl + idx * 6144 + 0 * 1024, modl + idx * 6144 + 1 * 1024, Abuf + (size_t)row * DM, lane);
            }
        }
        SEAM(ph); ++ph;
        if (RUN(ph)) {
            pg8::Gemm g{Abuf, Win, MTOT, Nin, DM}; pg8::StaticOrder S; S.init(MTOT, Nin, gridDim.x, blockIdx.x);
            EpiQKV E{BIG, Nin, kind == 0 ? 0 : (kind == 1 ? 1280 : 2048), rope};
#ifndef DIS_G1
            pg8::gemm_phase<EpiQKV, pg8::StaticOrder, true, true>((LAS unsigned char*)lds, g, S, E);
#endif
        }
        SEAM(ph); ++ph;
        if (RUN(ph)) {
            if (kind == 0) {
#ifndef DIS_ML
                mlstm_scan(lds, BIG, P.in[11] + slot * 32, HF, HB, need_ctx);
#endif
            } else if (kind == 1) {
#ifndef DIS_SWA
                swa_phase(lds, BIG, Abuf, P.in[15], need_ctx);
#endif
            }
            else {
                float s1 = 0.f, s2 = 0.f;
                for (int i = 0; i < 64; ++i) { s1 += P.in[18][i] * P.in[19][i]; s2 += P.in[20][i] * P.in[21][i]; }
                const float lam_init = 0.47071301834358416f;
                const float lam = expf(s1) - expf(s2) + lam_init;
#ifndef DIS_DIFF
                diff_phase(lds, BIG, Abuf, P.in[22], lam, 1.f - lam_init, need_ctx);
#endif
            }
        }
        SEAM(ph); ++ph;
        if (kind == 0) {
            if (RUN(ph)) {
                THIN_IDS
                const float* hn = P.in[12] + slot * 1024;
                for (int row = gw; row < Mrows; row += NGW) mlstm_finish_row(HF, HB, BIG, hn, Abuf, row, lane);
            }
            SEAM(ph);
        }
        ++ph;
        if (RUN(ph)) {
            pg8::Gemm g{Abuf, Wout, Mrows, DM, DM}; pg8::StaticOrder S; S.init(Mrows, DM, gridDim.x, blockIdx.x);
            EpiResid E{hlat, hc, modl + 2 * 1024};
#ifndef DIS_G2
            pg8::gemm_phase<EpiResid, pg8::StaticOrder, true, true>((LAS unsigned char*)lds, g, S, E);
#endif
        }
        SEAM(ph); ++ph;
        if (RUN(ph)) {
            THIN_IDS
            const float* gn = P.in[7] + l * DM;
            for (int row = gw; row < Mrows; row += NGW) {
                const int idx = row < MLAT ? (row >> 11) : 8;
                const float* hrow = row < MLAT ? hlat + (size_t)row * DM : hc + (size_t)(row - MLAT) * DM;
                norm_row(hrow, gn, modl + idx * 6144 + 3 * 1024, modl + idx * 6144 + 4 * 1024, Abuf + (size_t)row * DM, lane);
            }
        }
        SEAM(ph); ++ph;
        if (RUN(ph)) {
            pg8::Gemm g{Abuf, W1, Mrows, DFF, DM}; pg8::StaticOrder S; S.init(Mrows, DFF, gridDim.x, blockIdx.x);
            EpiSqRelu E{BIG, DFF};
#ifndef DIS_G3
            pg8::gemm_phase<EpiSqRelu, pg8::StaticOrder, true, true>((LAS unsigned char*)lds, g, S, E);
#endif
        }
        SEAM(ph); ++ph;
        if (RUN(ph)) {
            pg8::Gemm g{BIG, W2, Mrows, DM, DFF}; pg8::StaticOrder S; S.init(Mrows, DM, gridDim.x, blockIdx.x);
            EpiResid E{hlat, hc, modl + 5 * 1024};
#ifndef DIS_G4
            pg8::gemm_phase<EpiResid, pg8::StaticOrder, true, true>((LAS unsigned char*)lds, g, S, E);
#endif
        }
        SEAM(ph); ++ph;
    }
    if (RUN(ph)) {
        THIN_IDS
        for (int row = gw; row < MLAT; row += NGW) {
            float* hrow = hlat + (size_t)row * DM;
            const f32x4* xr = (const f32x4*)hrow + lane;
            f32x4 v[4]; float s = 0.f;
#pragma unroll
            for (int j = 0; j < 4; ++j) { v[j] = xr[64 * j]; s += (v[j][0] * v[j][0] + v[j][1] * v[j][1]) + (v[j][2] * v[j][2] + v[j][3] * v[j][3]); }
            const float rstd = 1.f / sqrtf(wave_sum(s) * (1.f / DM) + EPS);
#pragma unroll
            for (int j = 0; j < 4; ++j) { const f32x4 gg = ((const f32x4*)P.in[24])[lane + 64 * j]; ((f32x4*)hrow)[lane + 64 * j] = v[j] * rstd * gg; }
        }
    }
#undef RUN
#undef SEAM
}
constexpr int N_PHASES = 1 + 8 * DEPTH + 1;

#ifndef MK_MULTI
#define MK_MULTI 0
#endif
extern "C" void kernel_launch(void* const* d_in, const int* in_sizes, int n_in, void* d_out, int out_size, void* d_ws, size_t ws_size, hipStream_t stream) {
    static int grid = 0;
    if (grid == 0) {
        if (n_in != 25 || ws_size < WS_END) { fprintf(stderr, "kernel_launch: unexpected n_in %d / ws_size %zu\n", n_in, ws_size); grid = -1; return; }
        int dev = 0, cus = 0, per_cu = 0;
        hipGetDevice(&dev); hipDeviceGetAttribute(&cus, hipDeviceAttributeMultiprocessorCount, dev);
        if (hipFuncSetAttribute((const void*)mega, hipFuncAttributeMaxDynamicSharedMemorySize, LDS_BYTES) != hipSuccess) { fprintf(stderr, "hipFuncSetAttribute failed\n"); grid = -1; return; }
        if (hipOccupancyMaxActiveBlocksPerMultiprocessor(&per_cu, (const void*)mega, NTHREADS, LDS_BYTES) != hipSuccess || per_cu < 1) { fprintf(stderr, "occupancy query: %d\n", per_cu); per_cu = 1; }
        (void)hipGetLastError();
        grid = cus * (per_cu > 1 ? 1 : per_cu);
    }
    if (grid < 0) return;
    Params p{};
    for (int i = 0; i < 25; ++i) p.in[i] = (const float*)d_in[i];
    p.out = (float*)d_out; p.ws = (unsigned char*)d_ws;
#if MK_MULTI
    for (int k = 0; k < N_PHASES; ++k) { p.ph_lo = k; p.ph_hi = k + 1; hipLaunchKernelGGL(mega, dim3(grid), dim3(NTHREADS), LDS_BYTES, stream, p); }
#else
    p.ph_lo = 0; p.ph_hi = N_PHASES;
    void* args[] = {&p};
    hipError_t e = hipLaunchCooperativeKernel((const void*)mega, dim3(grid), dim3(NTHREADS), args, LDS_BYTES, stream);
    if (e != hipSuccess) fprintf(stderr, "cooperative launch failed: %s (grid %d)\n", hipGetErrorString(e), grid);
#endif
}
```

```cpp
#include <hip/hip_runtime.h>
#include <hip/hip_cooperative_groups.h>
#include <cstdio>
#include <cstdint>
namespace cg = cooperative_groups;
namespace pg8 {
#define PG8_LAS __attribute__((address_space(3)))
typedef unsigned short bf16_t;
typedef short bf16x8 __attribute__((ext_vector_type(8)));
typedef float f32x4 __attribute__((ext_vector_type(4)));
typedef unsigned u32x4 __attribute__((ext_vector_type(4)));
constexpr int BM = 256, BK = 64, HALF = 128, HTB = HALF * BK * 2  , STAGE_BYTES = 8 * HTB, NXCD = 8, WGM = 8;

__host__ __device__ __forceinline__ int lds_byte(int r, int c) { const int st = (r >> 4) * 2 + (c >> 5), rr = r & 15, cc = c & 31, ob = rr * 64 + cc * 2; return st * 1024 + (ob ^ (((ob >> 9) & 1) << 5)); }
__host__ __device__ __forceinline__ void stage_rc(int b, int& R, int& C) { const int st = b / 1024, sb = b % 1024, swz = sb ^ (((sb >> 9) & 1) << 5); R = (st >> 1) * 16 + swz / 64; C = (st & 1) * 32 + (swz % 64) / 2; }
__host__ __device__ __forceinline__ int perm32(int rho) { const int n = rho >> 4, i = rho & 15; return 8 * (i >> 2) + 4 * n + (i & 3); }

struct Unit { int pm, pn; };
struct Gemm { const bf16_t* A; const bf16_t* Bt; int M, N, K; };

struct StaticOrder {
    int nM, nN, nwg, G, c;
    __host__ __device__ void init(int M, int N, int G_, int c_) { nM = M / BM; nN = N / BM; nwg = nM * nN; G = G_; c = c_; }
    __host__ __device__ bool next(int i, Unit& u) const {
        const long L = (long)i * G + c; if (L >= nwg) return false;
        int wgid = (int)L; { const int q = nwg / NXCD, r = nwg % NXCD, xcd = wgid % NXCD, off = wgid / NXCD; wgid = (xcd < r ? xcd * (q + 1) : r * (q + 1) + (xcd - r) * q) + off; }
        const int nig = WGM * nN, gid = wgid / nig, fm = gid * WGM, gsz = (nM - fm) < WGM ? (nM - fm) : WGM;
        u.pm = fm + ((wgid % nig) % gsz); u.pn = (wgid % nig) / gsz; return true;
    }
    __device__ __forceinline__ void a_ready(const Unit&) const {}
    __device__ __forceinline__ void done(const Unit&) const {}
};

__device__ __forceinline__ unsigned cvt_pk_bf16(float lo, float hi) { unsigned r; asm volatile("v_cvt_pk_bf16_f32 %0, %1, %2" : "=v"(r) : "v"(lo), "v"(hi)); return r; }
template <class Epi, class Sched, bool ALIGN_EPI = false, bool SP2 = false>
__device__ __forceinline__ void gemm_phase(PG8_LAS unsigned char* lds, const Gemm g, const Sched& S, const Epi& E) {
    int tid_o = threadIdx.x; asm volatile("" : "+v"(tid_o)); const int tid = tid_o, wid = __builtin_amdgcn_readfirstlane(tid >> 6), lane = tid & 63, wr = wid >> 2, wc = wid & 3, fr = lane & 15, fq = lane >> 4;
    const int K = g.K, nt = K / BK;
    unsigned voffA[2], voffB[2];
#pragma unroll
    for (int i = 0; i < 2; ++i) { int R, C; stage_rc(tid * 16 + i * 8192, R, C); const int Rb = Epi::PERM ? ((R & ~31) + perm32(R & 31)) : R;
        voffA[i] = (unsigned)(R * K + C) * 2u; voffB[i] = (unsigned)(Rb * K + C) * 2u; }
    const size_t kstep = (size_t)(BK * 2);
    const size_t hstep = (size_t)HALF * K * 2;
    const size_t tstep = 2 * hstep;
    const unsigned ldsw = (unsigned)wid * 1024u;
    const int aoff = lds_byte(wr * 64 + fr, fq * 8), boff = lds_byte(wc * 32 + fr, fq * 8);
#define PG8_SA(b, h) (((b) * 2 + (h)) * HTB)
#define PG8_SB(b, h) ((4 + (b) * 2 + (h)) * HTB)
#define PG8_STAGE(bufoff, gbase, voff) do { _Pragma("unroll") for (int _i = 0; _i < 2; ++_i) \
        __builtin_amdgcn_global_load_lds((const unsigned*)((const char*)(gbase) + (voff)[_i]), (PG8_LAS unsigned*)(lds + (bufoff) + ldsw + _i * 8192), 16, 0, 0); } while (0)
#define PG8_LDA(dst, b, h) do { _Pragma("unroll") for (int m = 0; m < 4; ++m) _Pragma("unroll") for (int k = 0; k < 2; ++k) dst[m][k] = *(const PG8_LAS bf16x8*)(lds + PG8_SA(b, h) + aoff + m * 2048 + k * 1024); } while (0)
#define PG8_LDB(dst, b, h) do { _Pragma("unroll") for (int n = 0; n < 2; ++n) _Pragma("unroll") for (int k = 0; k < 2; ++k) dst[n][k] = *(const PG8_LAS bf16x8*)(lds + PG8_SB(b, h) + boff + n * 2048 + k * 1024); } while (0)
#define PG8_MMA(ai, bj, At, Bt) do { __builtin_amdgcn_s_setprio(1); _Pragma("unroll") for (int m = 0; m < 4; ++m) _Pragma("unroll") for (int n = 0; n < 2; ++n) _Pragma("unroll") for (int k = 0; k < 2; ++k) \
        acc[ai][bj][m][n] = __builtin_amdgcn_mfma_f32_16x16x32_bf16(Bt[n][k], At[m][k], acc[ai][bj][m][n], 0, 0, 0); __builtin_amdgcn_s_setprio(0); } while (0)
#define PG8_WAIT_V(n) asm volatile("s_waitcnt vmcnt(" #n ")" ::: "memory")
#define PG8_WAIT_L(n) asm volatile("s_waitcnt lgkmcnt(" #n ")" ::: "memory")
#define PG8_BAR __builtin_amdgcn_s_barrier()
#define PG8_SCHED __builtin_amdgcn_sched_barrier(0)
    Unit cur, nxt; int ui = 0;
    if (!S.next(0, cur)) return;
    f32x4 acc[2][2][4][2];
#pragma unroll
    for (int a = 0; a < 2; ++a)
#pragma unroll
        for (int b = 0; b < 2; ++b)
#pragma unroll
            for (int m = 0; m < 4; ++m)
#pragma unroll
                for (int n = 0; n < 2; ++n) acc[a][b][m][n] = (f32x4){0.f, 0.f, 0.f, 0.f};
    bf16x8 At[4][2], B0[2][2], B1[2][2];
    const char* cA = (const char*)g.A + (size_t)cur.pm * tstep; const char* cB = (const char*)g.Bt + (size_t)cur.pn * tstep;
    S.a_ready(cur);
    if constexpr (SP2) {
        PG8_STAGE(PG8_SB(0, 0), cB, voffB); PG8_STAGE(PG8_SB(0, 1), cB + hstep, voffB); PG8_STAGE(PG8_SA(0, 0), cA, voffA); PG8_STAGE(PG8_SA(0, 1), cA + hstep, voffA);
        if (wr == 1) PG8_BAR;
        PG8_WAIT_V(2); PG8_BAR;
        PG8_STAGE(PG8_SB(1, 0), cB + kstep, voffB); PG8_STAGE(PG8_SA(1, 0), cA + kstep, voffA); PG8_STAGE(PG8_SB(1, 1), cB + hstep + kstep, voffB);
        PG8_WAIT_V(6); PG8_BAR;
    } else {
        PG8_STAGE(PG8_SB(0, 0), cB, voffB); PG8_STAGE(PG8_SA(0, 0), cA, voffA); PG8_STAGE(PG8_SB(0, 1), cB + hstep, voffB); PG8_STAGE(PG8_SA(0, 1), cA + hstep, voffA);
        if (wr == 1) PG8_BAR;
        PG8_WAIT_V(4); PG8_BAR;
        PG8_STAGE(PG8_SB(1, 0), cB + kstep, voffB); PG8_STAGE(PG8_SA(1, 0), cA + kstep, voffA); PG8_STAGE(PG8_SB(1, 1), cB + hstep + kstep, voffB);
        PG8_WAIT_V(6); PG8_BAR;
    }
    for (;;) {
        const bool has_next = S.next(ui + 1, nxt);
        const char* nA = has_next ? (const char*)g.A + (size_t)nxt.pm * tstep : cA; const char* nB = has_next ? (const char*)g.Bt + (size_t)nxt.pn * tstep : cB;
        for (int t = 0; t < nt; t += 2) {
            const bool last = (t == nt - 2);
            const char* a1 = cA + (size_t)(t + 1) * kstep;
            const char* a2 = last ? nA : cA + (size_t)(t + 2) * kstep; const char* b2 = last ? nB : cB + (size_t)(t + 2) * kstep;
            const char* a3 = a2 + kstep; const char* b3 = b2 + kstep;
            if (last && has_next) S.a_ready(nxt);
            if constexpr (SP2) {
            PG8_LDB(B0, 0, 0); PG8_LDB(B1, 0, 1); PG8_SCHED; PG8_LDA(At, 0, 0); PG8_STAGE(PG8_SA(1, 1), a1 + hstep, voffA);
            PG8_WAIT_V(8); PG8_WAIT_L(0); PG8_BAR; PG8_MMA(0, 0, At, B0); PG8_MMA(0, 1, At, B1); PG8_BAR; PG8_SCHED;
            PG8_LDA(At, 0, 1); PG8_STAGE(PG8_SB(0, 0), b2, voffB); PG8_STAGE(PG8_SB(0, 1), b2 + hstep, voffB); PG8_STAGE(PG8_SA(0, 0), a2, voffA);
            PG8_WAIT_V(8); PG8_WAIT_L(0); PG8_BAR; PG8_MMA(1, 0, At, B0); PG8_MMA(1, 1, At, B1); PG8_BAR; PG8_SCHED;
            PG8_LDB(B0, 1, 0); PG8_LDB(B1, 1, 1); PG8_SCHED; PG8_LDA(At, 1, 0); PG8_STAGE(PG8_SA(0, 1), a2 + hstep, voffA);
            PG8_WAIT_V(8); PG8_WAIT_L(0); PG8_BAR; PG8_MMA(0, 0, At, B0); PG8_MMA(0, 1, At, B1); PG8_BAR; PG8_SCHED;
            PG8_LDA(At, 1, 1); PG8_STAGE(PG8_SB(1, 0), b3, voffB); PG8_STAGE(PG8_SB(1, 1), b3 + hstep, voffB); PG8_STAGE(PG8_SA(1, 0), a3, voffA);
            PG8_WAIT_V(8); PG8_WAIT_L(0); PG8_BAR; PG8_MMA(1, 0, At, B0); PG8_MMA(1, 1, At, B1); PG8_BAR; PG8_SCHED;
            } else {
            PG8_LDB(B0, 0, 0); PG8_SCHED; PG8_LDA(At, 0, 0); PG8_STAGE(PG8_SA(1, 1), a1 + hstep, voffA);
            PG8_WAIT_L(8); PG8_BAR; PG8_WAIT_L(0); PG8_MMA(0, 0, At, B0); PG8_BAR; PG8_SCHED;
            PG8_LDB(B1, 0, 1); PG8_STAGE(PG8_SB(0, 0), b2, voffB);
            PG8_BAR; PG8_WAIT_L(0); PG8_MMA(0, 1, At, B1); PG8_BAR;
            PG8_LDA(At, 0, 1); PG8_STAGE(PG8_SA(0, 0), a2, voffA);
            PG8_BAR; PG8_WAIT_L(0); PG8_MMA(1, 0, At, B0); PG8_BAR; PG8_SCHED;
            PG8_STAGE(PG8_SB(0, 1), b2 + hstep, voffB);
            PG8_WAIT_V(6); PG8_BAR; PG8_MMA(1, 1, At, B1); PG8_BAR;
            PG8_LDB(B0, 1, 0); PG8_SCHED; PG8_LDA(At, 1, 0); PG8_STAGE(PG8_SA(0, 1), a2 + hstep, voffA);
            PG8_WAIT_L(8); PG8_BAR; PG8_WAIT_L(0); PG8_MMA(0, 0, At, B0); PG8_BAR; PG8_SCHED;
            PG8_LDB(B1, 1, 1); PG8_STAGE(PG8_SB(1, 0), b3, voffB);
            PG8_BAR; PG8_WAIT_L(0); PG8_MMA(0, 1, At, B1); PG8_BAR;
            PG8_LDA(At, 1, 1); PG8_STAGE(PG8_SA(1, 0), a3, voffA);
            PG8_BAR; PG8_WAIT_L(0); PG8_MMA(1, 0, At, B0); PG8_BAR; PG8_SCHED;
            PG8_STAGE(PG8_SB(1, 1), b3 + hstep, voffB);
            PG8_WAIT_V(6); PG8_BAR; PG8_MMA(1, 1, At, B1); PG8_BAR;
            }
        }
        if constexpr (ALIGN_EPI) { if (wr == 0) PG8_BAR; }
        if constexpr (!Epi::AFTER_DRAIN) { E(acc, cur, wr, wc, fr, fq); S.done(cur); }
        if (!has_next) break;
#pragma unroll
        for (int a = 0; a < 2; ++a)
#pragma unroll
            for (int b = 0; b < 2; ++b)
#pragma unroll
                for (int m = 0; m < 4; ++m)
#pragma unroll
                    for (int n = 0; n < 2; ++n) acc[a][b][m][n] = (f32x4){0.f, 0.f, 0.f, 0.f};
        cur = nxt; cA = nA; cB = nB; ++ui;
        if constexpr (ALIGN_EPI) { if (wr == 1) PG8_BAR; }
    }
    PG8_WAIT_V(0);
    if constexpr (!ALIGN_EPI) { if (wr == 0) PG8_BAR; }
    PG8_BAR;
    if constexpr (Epi::AFTER_DRAIN) { E.fused(acc, cur, wr, wc, fr, fq, lds, wid, lane); S.done(cur); }
#undef PG8_SA
#undef PG8_SB
#undef PG8_STAGE
#undef PG8_LDA
#undef PG8_LDB
#undef PG8_MMA
#undef PG8_WAIT_V
#undef PG8_WAIT_L
#undef PG8_BAR
#undef PG8_SCHED
}
}
using pg8::bf16_t; using pg8::bf16x8; using pg8::f32x4; using pg8::u32x4;
#define LAS __attribute__((address_space(3)))
#define DI __device__ __forceinline__
typedef short s16x4 __attribute__((ext_vector_type(4)));
typedef short v4i16_t __attribute__((ext_vector_type(4)));
typedef float f32x16 __attribute__((ext_vector_type(16)));
typedef float f32x2_t __attribute__((ext_vector_type(2)));
typedef __bf16 bf16x2_t __attribute__((ext_vector_type(2)));
typedef unsigned u32x2 __attribute__((ext_vector_type(2)));
#define MFMA32(a, b, c) __builtin_amdgcn_mfma_f32_32x32x16_bf16((a), (b), (c), 0, 0, 0)

constexpr int DM = 1024, NB = 8, SEQ = 2048, CTX = 256, DEPTH = 4, DFF = 4096;
constexpr int MLAT = NB * SEQ, MCTX = NB * CTX, MTOT = MLAT + MCTX;
constexpr int NIN_A = 3328, NIN_B = 1536, NIN_C = 3072;
constexpr float EPS = 1e-6f;
constexpr size_t MiB = 1u << 20;
constexpr size_t WS_BARW = 1 * MiB + 768 * 1024;
constexpr size_t WS_MODS = 0, WS_ROPE = 1 * MiB, WS_HC = 2 * MiB, WS_WIN = 10 * MiB, WS_WOUT = 17 * MiB, WS_W1 = 19 * MiB, WS_W2 = 27 * MiB,
                 WS_ABUF = 36 * MiB, WS_BIG = 72 * MiB, WS_HF = 216 * MiB, WS_HB = 252 * MiB, WS_END = 288 * MiB;
constexpr int LDS_BYTES = 147456;
constexpr int NTHREADS = 512;

struct Params { const float* in[25]; float* out; unsigned char* ws; int ph_lo, ph_hi; };

DI unsigned pk2(float lo, float hi) { f32x2_t v = {lo, hi}; bf16x2_t b = __builtin_convertvector(v, bf16x2_t); return __builtin_bit_cast(unsigned, b); }
DI float bflo(unsigned u) { return __uint_as_float(u << 16); }
DI float bfhi(unsigned u) { return __uint_as_float(u & 0xffff0000u); }
DI float bf1(unsigned short u) { return __uint_as_float(((unsigned)u) << 16); }
DI float wave_sum(float v) {
#pragma unroll
    for (int o = 1; o < 64; o <<= 1) v += __shfl_xor(v, o);
    return v;
}
DI int crow(int i, int h) { return (i & 3) + 8 * (i >> 2) + 4 * h; }
DI s16x4 vtr(const LAS char* p) { return __builtin_bit_cast(s16x4, __builtin_amdgcn_ds_read_tr16_b64_v4i16((LAS v4i16_t*)p)); }
DI bf16x8 cat8(s16x4 lo, s16x4 hi) { return __builtin_shufflevector(lo, hi, 0, 1, 2, 3, 4, 5, 6, 7); }
template <int S> DI bf16x8 packP(const f32x16& x) {
    u32x4 p; p.x = pk2(x[8 * S + 0], x[8 * S + 1]); p.y = pk2(x[8 * S + 2], x[8 * S + 3]); p.z = pk2(x[8 * S + 4], x[8 * S + 5]); p.w = pk2(x[8 * S + 6], x[8 * S + 7]);
    return __builtin_bit_cast(bf16x8, p);
}
#define LDS_WAIT() asm volatile("s_waitcnt lgkmcnt(0)" ::: "memory")

struct EpiQKV {
    static constexpr bool PERM = true, AFTER_DRAIN = false;
    bf16_t* O; int ldc; int rope_cols; const float* rope;
    DI void operator()(const f32x4 (&acc)[2][2][4][2], const pg8::Unit& u, int wr, int wc, int fr, int fq) const {
        const int row0 = u.pm * 256 + wr * 64 + fr, col0 = u.pn * 256 + wc * 32 + 8 * fq;
        const bool do_rope = (u.pn * 256 < rope_cols) && (u.pm < 64);
#pragma unroll
        for (int ai = 0; ai < 2; ++ai)
#pragma unroll
            for (int m = 0; m < 4; ++m) {
                const int row = row0 + ai * 128 + m * 16; bf16_t* rowp = O + (size_t)row * ldc + col0; const int t = row & 2047;
#pragma unroll
                for (int bj = 0; bj < 2; ++bj) {
                    f32x4 v0 = acc[ai][bj][m][0], v1 = acc[ai][bj][m][1];
                    if (do_rope) {
                        const int j0 = ((col0 + bj * 128) & 63) >> 1;
                        const f32x4 cs0 = *(const f32x4*)(rope + (size_t)(t * 32 + j0) * 2), cs1 = *(const f32x4*)(rope + (size_t)(t * 32 + j0) * 2 + 4);
                        f32x4 r0, r1;
                        r0[0] = v0[0] * cs0[0] - v0[1] * cs0[1]; r0[1] = v0[0] * cs0[1] + v0[1] * cs0[0];
                        r0[2] = v0[2] * cs0[2] - v0[3] * cs0[3]; r0[3] = v0[2] * cs0[3] + v0[3] * cs0[2];
                        r1[0] = v1[0] * cs1[0] - v1[1] * cs1[1]; r1[1] = v1[0] * cs1[1] + v1[1] * cs1[0];
                        r1[2] = v1[2] * cs1[2] - v1[3] * cs1[3]; r1[3] = v1[2] * cs1[3] + v1[3] * cs1[2];
                        v0 = r0; v1 = r1;
                    }
                    u32x4 w; w.x = pk2(v0[0], v0[1]); w.y = pk2(v0[2], v0[3]); w.z = pk2(v1[0], v1[1]); w.w = pk2(v1[2], v1[3]);
                    *(u32x4*)(rowp + bj * 128) = w;
                }
            }
    }
};
struct EpiSqRelu {
    static constexpr bool PERM = true, AFTER_DRAIN = false;
    bf16_t* O; int ldc;
    DI void operator()(const f32x4 (&acc)[2][2][4][2], const pg8::Unit& u, int wr, int wc, int fr, int fq) const {
        const int row0 = u.pm * 256 + wr * 64 + fr, col0 = u.pn * 256 + wc * 32 + 8 * fq;
#pragma unroll
        for (int ai = 0; ai < 2; ++ai)
#pragma unroll
            for (int m = 0; m < 4; ++m) {
                bf16_t* rowp = O + (size_t)(row0 + ai * 128 + m * 16) * ldc + col0;
#pragma unroll
                for (int bj = 0; bj < 2; ++bj) {
                    f32x4 v0 = acc[ai][bj][m][0], v1 = acc[ai][bj][m][1];
#pragma unroll
                    for (int e = 0; e < 4; ++e) { float a = fmaxf(v0[e], 0.f), b = fmaxf(v1[e], 0.f); v0[e] = a * a; v1[e] = b * b; }
                    u32x4 w; w.x = pk2(v0[0], v0[1]); w.y = pk2(v0[2], v0[3]); w.z = pk2(v1[0], v1[1]); w.w = pk2(v1[2], v1[3]);
                    *(u32x4*)(rowp + bj * 128) = w;
                }
            }
    }
};
struct EpiResid {
    static constexpr bool PERM = true, AFTER_DRAIN = false;
    float* hlat; float* hctx; const float* gate_base; float gscale;
    DI void operator()(const f32x4 (&acc)[2][2][4][2], const pg8::Unit& u, int wr, int wc, int fr, int fq) const {
        const int idx = u.pm < 64 ? (u.pm >> 3) : 8;
        float* hb = u.pm < 64 ? hlat + (size_t)u.pm * 256 * DM : hctx + (size_t)(u.pm - 64) * 256 * DM;
        const int col0 = u.pn * 256 + wc * 32 + 8 * fq;
        const float* gp = gate_base + idx * 6144 + col0;
        float* rowp0 = hb + (size_t)(wr * 64 + fr) * DM + col0;
#pragma unroll
        for (int bj = 0; bj < 2; ++bj)
#pragma unroll
            for (int n = 0; n < 2; ++n) {
                const f32x4 g = *(const f32x4*)(gp + bj * 128 + 4 * n) * gscale;
#pragma unroll
                for (int ai = 0; ai < 2; ++ai)
#pragma unroll
                    for (int m = 0; m < 4; ++m) {
                        float* p = rowp0 + (size_t)(ai * 128 + m * 16) * DM + bj * 128 + 4 * n;
                        f32x4 h0 = *(f32x4*)p; h0 = h0 + g * acc[ai][bj][m][n]; *(f32x4*)p = h0;
                    }
            }
    }
};

DI void norm_row(const float* hrow, const float* g, const float* shift, const float* scale, bf16_t* orow, int lane) {
    const f32x4* xr = (const f32x4*)hrow + lane;
    f32x4 v[4]; float s = 0.f;
#pragma unroll
    for (int j = 0; j < 4; ++j) { v[j] = xr[64 * j]; s += (v[j][0] * v[j][0] + v[j][1] * v[j][1]) + (v[j][2] * v[j][2] + v[j][3] * v[j][3]); }
    const float rstd = 1.f / sqrtf(wave_sum(s) * (1.f / DM) + EPS);
    u32x2* o8 = (u32x2*)orow + lane;
#pragma unroll
    for (int j = 0; j < 4; ++j) {
        const f32x4 gg = ((const f32x4*)g)[lane + 64 * j];
        f32x4 y = v[j] * rstd * gg;
        if (shift) { const f32x4 sh = ((const f32x4*)shift)[lane + 64 * j], sc = ((const f32x4*)scale)[lane + 64 * j]; y = y * (sc + 1.f) + sh; }
        u32x2 w; w.x = pk2(y[0], y[1]); w.y = pk2(y[2], y[3]); o8[64 * j] = w;
    }
}
struct ConvDesc { const float* W; bf16_t* WT; int K, Nsrc, Ndst, rope_cols, sc_lo, sc_hi; };
DI void conv_item(const ConvDesc& d, LAS float* scr, int item, int lane) {
    const int nblk = d.Ndst / 32, kb = item / nblk, nb = item % nblk, k0 = 64 * kb, n0 = 32 * nb;
    const int q = lane & 31, nd = n0 + q;
    int ns = nd;
    if (nd < d.rope_cols) { const int head = nd >> 6, p = nd & 63; ns = head * 64 + (p >> 1) + 32 * (p & 1); }
    const bool valid = ns < d.Nsrc;
    const float scl = (nd >= d.sc_lo && nd < d.sc_hi) ? 0.125f : 1.f;
    const float* src = d.W + (size_t)k0 * d.Nsrc + (valid ? ns : 0);
#pragma unroll 8
    for (int i = 0; i < 32; ++i) { const int kk = 2 * i + (lane >> 5); const float w = src[(size_t)kk * d.Nsrc]; scr[kk * 33 + q] = valid ? w * scl : 0.f; }
    LDS_WAIT();
    const int c = lane & 7;
#pragma unroll
    for (int j = 0; j < 4; ++j) {
        const int n = (lane >> 3) + 8 * j; const LAS float* s = scr + (8 * c) * 33 + n;
        u32x4 o; o.x = pk2(s[0 * 33], s[1 * 33]); o.y = pk2(s[2 * 33], s[3 * 33]); o.z = pk2(s[4 * 33], s[5 * 33]); o.w = pk2(s[6 * 33], s[7 * 33]);
        *(u32x4*)(d.WT + (size_t)(n0 + n) * d.K + k0 + 8 * c) = o;
    }
    LDS_WAIT();
}
#define XB_TMO      128
#define XB_XCNT(j)  (256  + 64 * (j))
#define XB_XSUB(j)  (1280 + 64 * (j))
#define XB_XGEN(j)  (2304 + 64 * (j))
#define XB_TOP      3328
#define XB_TOPGEN   3392
#define XCD_BAR_WORDS 3456
#define XB_SPIN_CAP (1u << 18)

__device__ __forceinline__ unsigned xb_ld(unsigned* p)              { return __hip_atomic_load(p, __ATOMIC_RELAXED, __HIP_MEMORY_SCOPE_AGENT); }
__device__ __forceinline__ unsigned xb_add(unsigned* p, unsigned v) { return __hip_atomic_fetch_add(p, v, __ATOMIC_RELAXED, __HIP_MEMORY_SCOPE_AGENT); }
__device__ __forceinline__ unsigned xb_xcc_id() { return (unsigned)__builtin_amdgcn_s_getreg((3 << 11) | 20) & 0xFu; }
#define XB_SPIN(cond, bar) do { unsigned _sp = 0; while (cond) { __builtin_amdgcn_s_sleep(1); \
    if ((++_sp & 255u) == 0u) { if (xb_ld(&(bar)[XB_TMO])) break; if (_sp > XB_SPIN_CAP) { atomicAdd(&(bar)[XB_TMO], 1u); break; } } } } while (0)

struct XcdBarrier {
    unsigned* bar; unsigned x;
    volatile __attribute__((address_space(3))) unsigned* st;
};

__device__ __forceinline__ XcdBarrier xcd_barrier_post(unsigned* bar, volatile __attribute__((address_space(3))) unsigned* st) {
    XcdBarrier b; b.bar = bar; b.x = xb_xcc_id(); b.st = st;
    if (threadIdx.x == 0) (void)xb_add(&bar[XB_XCNT(b.x)], 1u);
    return b;
}
__device__ __forceinline__ void xcd_barrier_complete(unsigned* bar, unsigned x, unsigned& nloc, unsigned& nx) {
    const unsigned G = gridDim.x * gridDim.y * gridDim.z;
    unsigned sum, cnt, mine, sp = 0u;
    for (;;) {
        sum = 0u; cnt = 0u; mine = 0u;
#pragma unroll
        for (unsigned j = 0; j < 16; ++j) { const unsigned c = xb_ld(&bar[XB_XCNT(j)]); sum += c; cnt += (c > 0u) ? 1u : 0u; mine = (j == x) ? c : mine; }
        if (sum == G) break;
        __builtin_amdgcn_s_sleep(1);
        if ((++sp & 255u) == 0u) { if (xb_ld(&bar[XB_TMO])) break; if (sp > XB_SPIN_CAP) { atomicAdd(&bar[XB_TMO], 1u); break; } }
    }
    nloc = mine > 0u ? mine : 1u; nx = cnt > 0u ? cnt : 1u;
}

__device__ __forceinline__ void xcd_barrier(const XcdBarrier& b) {
    asm volatile("s_waitcnt vmcnt(0)" ::: "memory");
    __syncthreads();
    if (threadIdx.x == 0) {
        unsigned* bar = b.bar;
        __builtin_amdgcn_s_waitcnt(0);
        unsigned nloc = b.st[0], nx = b.st[1];
        if (nloc == 0u) { xcd_barrier_complete(bar, b.x, nloc, nx); b.st[0] = nloc; b.st[1] = nx; }
        const unsigned old = xb_add(&bar[XB_XSUB(b.x)], 1u);
        const unsigned gen = old / nloc;
        if (old + 1u == (gen + 1u) * nloc) {
            __builtin_amdgcn_fence(__ATOMIC_RELEASE, "agent");
            asm volatile("s_waitcnt vmcnt(0)" ::: "memory");
            const unsigned og = xb_add(&bar[XB_TOP], 1u);
            const unsigned tg = og / nx;
            if (og + 1u == (tg + 1u) * nx) xb_add(&bar[XB_TOPGEN], 1u);
            else XB_SPIN(xb_ld(&bar[XB_TOPGEN]) == tg, bar);
            __builtin_amdgcn_fence(__ATOMIC_ACQUIRE, "agent");
            xb_add(&bar[XB_XGEN(b.x)], 1u);
            asm volatile("s_waitcnt vmcnt(0)" ::: "memory");
        } else {
            XB_SPIN(xb_ld(&bar[XB_XGEN(b.x)]) == gen, bar);
            __builtin_amdgcn_fence(__ATOMIC_ACQUIRE, "agent");
            asm volatile("s_waitcnt vmcnt(0)" ::: "memory");
        }
    }
    __syncthreads();
}
DI void swa_phase(LAS char* lds, const bf16_t* QKV, bf16_t* Obuf, const float* sink, bool need_ctx) {
    int tid_ = threadIdx.x; asm volatile("" : "+v"(tid_)); const int tid = tid_, lane = tid & 63, w = __builtin_amdgcn_readfirstlane(tid >> 6), r = lane & 31, h = lane >> 5;
    const int g = w >> 1, th = w & 1;
    const int i16 = lane & 15, q4 = i16 >> 2, p4 = i16 & 3, g1 = (lane >> 4) & 1;
    LAS char* Kimg = lds; LAS char* Vimg = lds + 9216;
    const int srow = tid >> 3, piece = tid & 7;
    const int nunits = 1024 + (need_ctx ? 128 : 0);
    for (int u = blockIdx.x; u < nunits; u += gridDim.x) {
        int b, kvh, qrow0, t0 = 0, c_lo = 0, n_lat = 0;
        if (u < 1024) { b = u >> 7; kvh = (u >> 5) & 3; t0 = (u & 31) * 64; qrow0 = b * SEQ + t0;
            c_lo = t0 == 0 ? 2 : (t0 == 64 ? 1 : 0); int c_hi = (2176 - t0) / 64; if (c_hi > 5) c_hi = 5; n_lat = c_hi - c_lo; }
        else { const int v = u - 1024; b = v >> 4; kvh = (v >> 2) & 3; qrow0 = MLAT + b * CTX + (v & 3) * 64; }
        const int n = n_lat + 4;
        const int qrow = qrow0 + 32 * th + r, hq = kvh * 4 + g;
        bf16x8 qf[4];
#pragma unroll
        for (int s = 0; s < 4; ++s) qf[s] = *(const bf16x8*)(QKV + (size_t)qrow * NIN_B + hq * 64 + 16 * s + 8 * h);
        float m = sink[hq], l = (h == 0) ? 1.f : 0.f;
        f32x16 O[2];
#pragma unroll
        for (int i = 0; i < 16; ++i) { O[0][i] = 0.f; O[1][i] = 0.f; }
        u32x4 kreg, vreg;
        { const int base = (0 < n_lat) ? b * SEQ + t0 - 128 + 64 * c_lo : MLAT + b * CTX;
          const bf16_t* gp = QKV + (size_t)(base + srow) * NIN_B + kvh * 64 + piece * 8; kreg = *(const u32x4*)(gp + 1024); vreg = *(const u32x4*)(gp + 1280); }
        for (int i = 0; i < n; ++i) {
            __syncthreads();
            *(LAS u32x4*)(Kimg + srow * 144 + piece * 16) = kreg; *(LAS u32x4*)(Vimg + srow * 144 + piece * 16) = vreg;
            __syncthreads();
            if (i + 1 < n) { const int ii = i + 1; const int base = (ii < n_lat) ? b * SEQ + t0 - 128 + 64 * (c_lo + ii) : MLAT + b * CTX + 64 * (ii - n_lat);
                const bf16_t* gp = QKV + (size_t)(base + srow) * NIN_B + kvh * 64 + piece * 8; kreg = *(const u32x4*)(gp + 1024); vreg = *(const u32x4*)(gp + 1280); }
            const bool masked = i < n_lat; const int kpos0 = t0 - 128 + 64 * (c_lo + i), qp = t0 + 32 * th + r;
#pragma unroll
            for (int tile = 0; tile < 2; ++tile) {
                f32x16 S;
#pragma unroll
                for (int e = 0; e < 16; ++e) S[e] = 0.f;
#pragma unroll
                for (int s = 0; s < 4; ++s) { const bf16x8 kf = *(const LAS bf16x8*)(Kimg + (32 * tile + r) * 144 + (16 * s + 8 * h) * 2); S = MFMA32(kf, qf[s], S); }
                if (masked) {
#pragma unroll
                    for (int e = 0; e < 16; ++e) { const int d = kpos0 + 32 * tile + crow(e, h) - qp; if (d > 128 || d < -128) S[e] = -INFINITY; }
                }
                float tmax = S[0];
#pragma unroll
                for (int e = 1; e < 16; ++e) tmax = fmaxf(tmax, S[e]);
                tmax = fmaxf(tmax, __shfl_xor(tmax, 32));
                const float mn = fmaxf(m, tmax), alpha = __expf(m - mn); m = mn;
                float ls = 0.f;
#pragma unroll
                for (int e = 0; e < 16; ++e) { S[e] = __expf(S[e] - mn); ls += S[e]; }
                l = l * alpha + ls;
#pragma unroll
                for (int e = 0; e < 16; ++e) { O[0][e] *= alpha; O[1][e] *= alpha; }
                const bf16x8 pf0 = packP<0>(S), pf1 = packP<1>(S);
#pragma unroll
                for (int blk = 0; blk < 2; ++blk) {
                    const LAS char* vp = Vimg + (32 * tile + 4 * h + q4) * 144 + 2 * (32 * blk + 16 * g1) + 8 * p4;
                    const bf16x8 vf0 = cat8(vtr(vp), vtr(vp + 8 * 144)), vf1 = cat8(vtr(vp + 16 * 144), vtr(vp + 24 * 144));
                    O[blk] = MFMA32(vf0, pf0, O[blk]); O[blk] = MFMA32(vf1, pf1, O[blk]);
                }
            }
        }
        const float inv = 1.f / (l + __shfl_xor(l, 32));
        bf16_t* orow = Obuf + (size_t)qrow * DM + hq * 64 + 4 * h;
#pragma unroll
        for (int blk = 0; blk < 2; ++blk)
#pragma unroll
            for (int ig = 0; ig < 4; ++ig) { u32x2 o; o.x = pk2(O[blk][4 * ig] * inv, O[blk][4 * ig + 1] * inv); o.y = pk2(O[blk][4 * ig + 2] * inv, O[blk][4 * ig + 3] * inv);
                *(u32x2*)(orow + 32 * blk + 8 * ig) = o; }
    }
    __syncthreads();
}

DI void diff_phase(LAS char* lds, const bf16_t* QKV, bf16_t* Obuf, const float* hnorm, float lam, float one_m_lam_init, bool need_ctx) {
    int tid_ = threadIdx.x; asm volatile("" : "+v"(tid_)); const int tid = tid_, lane = tid & 63, w = __builtin_amdgcn_readfirstlane(tid >> 6), r = lane & 31, h = lane >> 5;
    const int mp = w >> 2, tb = w & 3;
    const int i16 = lane & 15, q4 = i16 >> 2, p4 = i16 & 3, g1 = (lane >> 4) & 1;
    LAS char* Kimg = lds; LAS char* Vimg = lds + 17408;
    LAS float* X = (LAS float*)(lds + 34816);
    const int srow = tid >> 3, piece = tid & 7;
    const int nunits = 1024 + (need_ctx ? 128 : 0);
    for (int u = blockIdx.x; u < nunits; u += gridDim.x) {
        int b, hh, qrow0, n_lat;
        if (u < 1024) { b = u >> 7; hh = (u >> 4) & 7; qrow0 = b * SEQ + (u & 15) * 128; n_lat = 32; }
        else { const int v = u - 1024; b = v >> 4; hh = (v >> 1) & 7; qrow0 = MLAT + b * CTX + (v & 1) * 128; n_lat = 0; }
        const int n = n_lat + 4;
        const int qrow = qrow0 + 32 * tb + r;
        bf16x8 qf[4];
#pragma unroll
        for (int s = 0; s < 4; ++s) qf[s] = *(const bf16x8*)(QKV + (size_t)qrow * NIN_C + (hh * 2 + mp) * 64 + 16 * s + 8 * h);
        float m = -INFINITY, l = 0.f;
        f32x16 O[4];
#pragma unroll
        for (int bk = 0; bk < 4; ++bk)
#pragma unroll
            for (int i = 0; i < 16; ++i) O[bk][i] = 0.f;
        u32x4 kreg[2], vreg[2];
        { const int base = (0 < n_lat) ? b * SEQ : MLAT + b * CTX;
          const bf16_t* gp = QKV + (size_t)(base + srow) * NIN_C + hh * 128 + piece * 8;
          kreg[0] = *(const u32x4*)(gp + 1024); kreg[1] = *(const u32x4*)(gp + 1024 + 64); vreg[0] = *(const u32x4*)(gp + 2048); vreg[1] = *(const u32x4*)(gp + 2048 + 64); }
        for (int i = 0; i < n; ++i) {
            __syncthreads();
            *(LAS u32x4*)(Kimg + srow * 272 + piece * 16) = kreg[0]; *(LAS u32x4*)(Kimg + srow * 272 + 128 + piece * 16) = kreg[1];
            *(LAS u32x4*)(Vimg + srow * 272 + piece * 16) = vreg[0]; *(LAS u32x4*)(Vimg + srow * 272 + 128 + piece * 16) = vreg[1];
            __syncthreads();
            if (i + 1 < n) { const int ii = i + 1; const int base = (ii < n_lat) ? b * SEQ + 64 * ii : MLAT + b * CTX + 64 * (ii - n_lat);
                const bf16_t* gp = QKV + (size_t)(base + srow) * NIN_C + hh * 128 + piece * 8;
                kreg[0] = *(const u32x4*)(gp + 1024); kreg[1] = *(const u32x4*)(gp + 1024 + 64); vreg[0] = *(const u32x4*)(gp + 2048); vreg[1] = *(const u32x4*)(gp + 2048 + 64); }
#pragma unroll
            for (int tile = 0; tile < 2; ++tile) {
                f32x16 S;
#pragma unroll
                for (int e = 0; e < 16; ++e) S[e] = 0.f;
#pragma unroll
                for (int s = 0; s < 4; ++s) { const bf16x8 kf = *(const LAS bf16x8*)(Kimg + (32 * tile + r) * 272 + mp * 128 + (16 * s + 8 * h) * 2); S = MFMA32(kf, qf[s], S); }
                float tmax = S[0];
#pragma unroll
                for (int e = 1; e < 16; ++e) tmax = fmaxf(tmax, S[e]);
                tmax = fmaxf(tmax, __shfl_xor(tmax, 32));
                const float mn = fmaxf(m, tmax), alpha = __expf(m - mn); m = mn;
                float ls = 0.f;
#pragma unroll
                for (int e = 0; e < 16; ++e) { S[e] = __expf(S[e] - mn); ls += S[e]; }
                l = l * alpha + ls;
#pragma unroll
                for (int bk = 0; bk < 4; ++bk)
#pragma unroll
                    for (int e = 0; e < 16; ++e) O[bk][e] *= alpha;
                const bf16x8 pf0 = packP<0>(S), pf1 = packP<1>(S);
#pragma unroll
                for (int blk = 0; blk < 4; ++blk) {
                    const LAS char* vp = Vimg + (32 * tile + 4 * h + q4) * 272 + 2 * (32 * blk + 16 * g1) + 8 * p4;
                    const bf16x8 vf0 = cat8(vtr(vp), vtr(vp + 8 * 272)), vf1 = cat8(vtr(vp + 16 * 272), vtr(vp + 24 * 272));
                    O[blk] = MFMA32(vf0, pf0, O[blk]); O[blk] = MFMA32(vf1, pf1, O[blk]);
                }
            }
        }
        const float inv = 1.f / (l + __shfl_xor(l, 32));
        if (mp == 1) {
#pragma unroll
            for (int blk = 0; blk < 4; ++blk)
#pragma unroll
                for (int e = 0; e < 16; ++e) X[(tb * 128 + 32 * blk + crow(e, h)) * 32 + r] = O[blk][e] * inv;
        }
        __syncthreads();
        if (mp == 0) {
            float ss = 0.f;
#pragma unroll
            for (int blk = 0; blk < 4; ++blk)
#pragma unroll
                for (int e = 0; e < 16; ++e) { const float od = O[blk][e] * inv - lam * X[(tb * 128 + 32 * blk + crow(e, h)) * 32 + r]; O[blk][e] = od; ss += od * od; }
            ss += __shfl_xor(ss, 32);
            const float rstd = one_m_lam_init / sqrtf(ss * (1.f / 128.f) + EPS);
            bf16_t* orow = Obuf + (size_t)qrow * DM + hh * 128 + 4 * h; const float* hn = hnorm + hh * 128 + 4 * h;
#pragma unroll
            for (int blk = 0; blk < 4; ++blk)
#pragma unroll
                for (int ig = 0; ig < 4; ++ig) { const f32x4 gn = *(const f32x4*)(hn + 32 * blk + 8 * ig);
                    u32x2 o; o.x = pk2(O[blk][4 * ig] * rstd * gn[0], O[blk][4 * ig + 1] * rstd * gn[1]); o.y = pk2(O[blk][4 * ig + 2] * rstd * gn[2], O[blk][4 * ig + 3] * rstd * gn[3]);
                    *(u32x2*)(orow + 32 * blk + 8 * ig) = o; }
        }
    }
    __syncthreads();
}
DI void mlstm_scan(LAS char* lds, const bf16_t* QKV, const float* gate_b, bf16_t* HF, bf16_t* HB, bool need_ctx) {
    int tid_ = threadIdx.x; asm volatile("" : "+v"(tid_)); const int tid = tid_, lane = tid & 63, w = __builtin_amdgcn_readfirstlane(tid >> 6), r = lane & 31, h = lane >> 5;
    const int tb = w & 3, dvh = w >> 2, dvb = w & 3, db = w >> 2;
    const int i16 = lane & 15, q4 = i16 >> 2, p4 = i16 & 3, g1 = (lane >> 4) & 1;
    LAS char* Qimg = lds;
    LAS char* Kimg = lds + 18432;
    LAS char* Vimg = lds + 36864;
    LAS char* Cimg = lds + 71680;
    LAS float* bvec = (LAS float*)(lds + 89088);
    LAS float* evec = bvec + 128;
    LAS float* cvec = bvec + 256;
    LAS float* n0 = bvec + 384;
    LAS float* npart = bvec + 448;
    LAS float* scal = bvec + 960;
    for (int it = blockIdx.x; it < 128; it += gridDim.x) {
        const int b = it >> 4, hh = (it >> 1) & 7, dir = it & 1;
        const float gb_i = gate_b[(2 * dir) * 8 + hh], gb_f = gate_b[(2 * dir + 1) * 8 + hh];
        bf16_t* HO = dir ? HB : HF;
        f32x16 Cacc;
#pragma unroll
        for (int e = 0; e < 16; ++e) Cacc[e] = 0.f;
        const int srow = tid >> 2, pc = tid & 3;
        u32x4 qreg[2], kreg[2], vreg[4]; float raw_i = 0.f, raw_f = 0.f;
#define ML_BASE(ci) ((ci) < 2 ? MLAT + b * CTX + 128 * (dir ? 1 - (ci) : (ci)) : b * SEQ + 128 * (dir ? 15 - ((ci) - 2) : ((ci) - 2)))
#define ML_LOAD(ci) do { const int base_ = ML_BASE(ci); const int grow_ = dir ? base_ + 127 - srow : base_ + srow; \
            const bf16_t* gp_ = QKV + (size_t)grow_ * NIN_A + hh * 64 + pc * 8; \
            qreg[0] = *(const u32x4*)(gp_); qreg[1] = *(const u32x4*)(gp_ + 32); kreg[0] = *(const u32x4*)(gp_ + 512); kreg[1] = *(const u32x4*)(gp_ + 512 + 32); \
            const bf16_t* gv_ = QKV + (size_t)grow_ * NIN_A + 1024 + hh * 128 + pc * 8; \
            vreg[0] = *(const u32x4*)(gv_); vreg[1] = *(const u32x4*)(gv_ + 32); vreg[2] = *(const u32x4*)(gv_ + 64); vreg[3] = *(const u32x4*)(gv_ + 96); \
            if (tid < 128) { const int gr2_ = dir ? base_ + 127 - tid : base_ + tid; const bf16_t* gg_ = QKV + (size_t)gr2_ * NIN_A + 3072 + (2 * dir) * 8 + hh; raw_i = bf1(gg_[0]); raw_f = bf1(gg_[8]); } } while (0)
        ML_LOAD(0);
        __syncthreads();
        for (int ci = 0; ci < 18; ++ci) {
            *(LAS u32x4*)(Qimg + srow * 144 + pc * 16) = qreg[0]; *(LAS u32x4*)(Qimg + srow * 144 + 64 + pc * 16) = qreg[1];
            *(LAS u32x4*)(Kimg + srow * 144 + pc * 16) = kreg[0]; *(LAS u32x4*)(Kimg + srow * 144 + 64 + pc * 16) = kreg[1];
#pragma unroll
            for (int k = 0; k < 4; ++k) *(LAS u32x4*)(Vimg + srow * 272 + 64 * k + pc * 16) = vreg[k];
            if (tid < 128) { const float xf = raw_f + gb_f; evec[tid] = raw_i + gb_i; bvec[tid] = fminf(xf, 0.f) - log1pf(__expf(-fabsf(xf))); }
#pragma unroll
            for (int ig = 0; ig < 4; ++ig) { u32x2 o; o.x = pk2(Cacc[4 * ig], Cacc[4 * ig + 1]); o.y = pk2(Cacc[4 * ig + 2], Cacc[4 * ig + 3]);
                *(LAS u32x2*)(Cimg + (32 * db + r) * 272 + 2 * (32 * dvb + 8 * ig + 4 * h)) = o; }
            if (tid < 64) { float nn = 0.f; if (ci > 0) { const float dec = __expf(scal[0] - scal[1]); nn = dec * n0[tid];
#pragma unroll
                    for (int p = 0; p < 8; ++p) nn += npart[p * 64 + tid]; }
                n0[tid] = nn; }
            __syncthreads();
            if (w == 0) {
                const float m0 = (ci > 0) ? scal[2] + scal[1] : 0.f;
                const float lf0 = bvec[2 * lane], lf1 = bvec[2 * lane + 1], li0 = evec[2 * lane], li1 = evec[2 * lane + 1];
                const float s2 = lf0 + lf1; float inc = s2;
#pragma unroll
                for (int o = 1; o < 64; o <<= 1) { const float v = __shfl_up(inc, o); if (lane >= o) inc += v; }
                const float b0 = inc - s2 + lf0, b1 = inc;
                const float e0 = li0 - b0, e1 = li1 - b1;
                float mx = fmaxf(e0, e1);
#pragma unroll
                for (int o = 1; o < 64; o <<= 1) { const float v = __shfl_up(mx, o); if (lane >= o) mx = fmaxf(mx, v); }
                float ex = __shfl_up(mx, 1); if (lane == 0) ex = -INFINITY;
                const float M0 = fmaxf(ex, e0), M1 = mx;
                LDS_WAIT();
                bvec[2 * lane] = b0; bvec[2 * lane + 1] = b1; evec[2 * lane] = e0; evec[2 * lane + 1] = e1;
                cvec[2 * lane] = fmaxf(M0, m0); cvec[2 * lane + 1] = fmaxf(M1, m0);
                if (lane == 63) { scal[0] = m0; scal[1] = fmaxf(M1, m0); scal[2] = b1; }
            }
            __syncthreads();
            if (ci + 1 < 18) ML_LOAD(ci + 1);
            const float m0 = scal[0], c127 = scal[1];
            {
                const int t = 32 * tb + r;
                const float c_t = cvec[t], b_t = bvec[t], cw = __expf(m0 - c_t);
                bf16x8 qf[4];
#pragma unroll
                for (int ks = 0; ks < 4; ++ks) qf[ks] = *(const LAS bf16x8*)(Qimg + t * 144 + (16 * ks + 8 * h) * 2);
                f32x16 acc[2];
#pragma unroll
                for (int e = 0; e < 16; ++e) { acc[0][e] = 0.f; acc[1][e] = 0.f; }
                float dn = 0.f;
#pragma unroll
                for (int ks = 0; ks < 4; ++ks) {
#pragma unroll
                    for (int blk = 0; blk < 2; ++blk) {
                        const LAS char* cp = Cimg + (16 * ks + 8 * h + q4) * 272 + 2 * (64 * dvh + 32 * blk + 16 * g1) + 8 * p4;
                        const bf16x8 cf = cat8(vtr(cp), vtr(cp + 4 * 272));
                        acc[blk] = MFMA32(cf, qf[ks], acc[blk]);
                    }
                    const u32x4 qu = __builtin_bit_cast(u32x4, qf[ks]); const LAS float* np = n0 + 16 * ks + 8 * h;
                    dn += bflo(qu.x) * np[0] + bfhi(qu.x) * np[1] + bflo(qu.y) * np[2] + bfhi(qu.y) * np[3] + bflo(qu.z) * np[4] + bfhi(qu.z) * np[5] + bflo(qu.w) * np[6] + bfhi(qu.w) * np[7];
                }
                dn += __shfl_xor(dn, 32);
#pragma unroll
                for (int e = 0; e < 16; ++e) { acc[0][e] *= cw; acc[1][e] *= cw; }
                float dsum = 0.f;
                for (int st = 0; st <= tb; ++st) {
                    f32x16 S;
#pragma unroll
                    for (int e = 0; e < 16; ++e) S[e] = 0.f;
#pragma unroll
                    for (int ks = 0; ks < 4; ++ks) { const bf16x8 kf = *(const LAS bf16x8*)(Kimg + (32 * st + r) * 144 + (16 * ks + 8 * h) * 2); S = MFMA32(kf, qf[ks], S); }
#pragma unroll
                    for (int e = 0; e < 16; ++e) { const int s = 32 * st + crow(e, h); const float wgt = (s <= t) ? __expf(evec[s] - c_t) : 0.f; S[e] *= wgt; dsum += S[e]; }
                    const bf16x8 pf0 = packP<0>(S), pf1 = packP<1>(S);
#pragma unroll
                    for (int blk = 0; blk < 2; ++blk) {
                        const LAS char* vp = Vimg + (32 * st + 4 * h + q4) * 272 + 2 * (64 * dvh + 32 * blk + 16 * g1) + 8 * p4;
                        const bf16x8 vf0 = cat8(vtr(vp), vtr(vp + 8 * 272)), vf1 = cat8(vtr(vp + 16 * 272), vtr(vp + 24 * 272));
                        acc[blk] = MFMA32(vf0, pf0, acc[blk]); acc[blk] = MFMA32(vf1, pf1, acc[blk]);
                    }
                }
                dsum += __shfl_xor(dsum, 32);
                const float den = dsum + cw * dn;
                const float inv = 1.f / fmaxf(fabsf(den), __expf(-(b_t + c_t)));
                if (ci >= 2 || need_ctx) {
                    const int base = ML_BASE(ci); const int orow_i = dir ? base + 127 - t : base + t;
                    bf16_t* orow = HO + (size_t)orow_i * DM + hh * 128 + 64 * dvh + 4 * h;
#pragma unroll
                    for (int blk = 0; blk < 2; ++blk)
#pragma unroll
                        for (int ig = 0; ig < 4; ++ig) { u32x2 o; o.x = pk2(acc[blk][4 * ig] * inv, acc[blk][4 * ig + 1] * inv); o.y = pk2(acc[blk][4 * ig + 2] * inv, acc[blk][4 * ig + 3] * inv);
                            *(u32x2*)(orow + 32 * blk + 8 * ig) = o; }
                }
            }
            {
                const float dec = __expf(m0 - c127);
#pragma unroll
                for (int e = 0; e < 16; ++e) Cacc[e] *= dec;
#pragma unroll
                for (int ks = 0; ks < 8; ++ks) {
                    const LAS char* vp = Vimg + (16 * ks + 8 * h + q4) * 272 + 2 * (32 * dvb + 16 * g1) + 8 * p4;
                    const bf16x8 vf = cat8(vtr(vp), vtr(vp + 4 * 272));
                    const LAS char* kp = Kimg + (16 * ks + 8 * h + q4) * 144 + 2 * (32 * db + 16 * g1) + 8 * p4;
                    const s16x4 klo = vtr(kp), khi = vtr(kp + 4 * 144);
                    const LAS float* ep = evec + 16 * ks + 8 * h;
                    float kw[8];
#pragma unroll
                    for (int j = 0; j < 4; ++j) { kw[j] = bf1((unsigned short)klo[j]) * __expf(ep[j] - c127); kw[4 + j] = bf1((unsigned short)khi[j]) * __expf(ep[4 + j] - c127); }
                    u32x4 kk; kk.x = pk2(kw[0], kw[1]); kk.y = pk2(kw[2], kw[3]); kk.z = pk2(kw[4], kw[5]); kk.w = pk2(kw[6], kw[7]);
                    Cacc = MFMA32(vf, __builtin_bit_cast(bf16x8, kk), Cacc);
                }
                const int d = tid & 63; float np_ = 0.f;
#pragma unroll
                for (int s = 0; s < 16; ++s) { const int ss = 16 * w + s; np_ += __expf(evec[ss] - c127) * bf1(*(const LAS unsigned short*)(Kimg + ss * 144 + 2 * d)); }
                npart[w * 64 + d] = np_;
            }
            __syncthreads();
        }
#undef ML_LOAD
#undef ML_BASE
    }
    __syncthreads();
}

DI void mlstm_finish_row(const bf16_t* HF, const bf16_t* HB, const bf16_t* QKV, const float* hnorm, bf16_t* Obuf, int row, int lane) {
    const int c0 = 16 * lane;
    const u32x4 f0 = *(const u32x4*)(HF + (size_t)row * DM + c0), f1 = *(const u32x4*)(HF + (size_t)row * DM + c0 + 8);
    const u32x4 b0 = *(const u32x4*)(HB + (size_t)row * DM + c0), b1 = *(const u32x4*)(HB + (size_t)row * DM + c0 + 8);
    const u32x4 o0 = *(const u32x4*)(QKV + (size_t)row * NIN_A + 2048 + c0), o1 = *(const u32x4*)(QKV + (size_t)row * NIN_A + 2048 + c0 + 8);
    float hs[16], og[16];
#pragma unroll
    for (int k = 0; k < 4; ++k) { hs[2 * k] = bflo(f0[k]) + bflo(b0[k]); hs[2 * k + 1] = bfhi(f0[k]) + bfhi(b0[k]); hs[8 + 2 * k] = bflo(f1[k]) + bflo(b1[k]); hs[8 + 2 * k + 1] = bfhi(f1[k]) + bfhi(b1[k]);
        og[2 * k] = bflo(o0[k]); og[2 * k + 1] = bfhi(o0[k]); og[8 + 2 * k] = bflo(o1[k]); og[8 + 2 * k + 1] = bfhi(o1[k]); }
    float ss = 0.f;
#pragma unroll
    for (int k = 0; k < 16; ++k) ss += hs[k] * hs[k];
    ss += __shfl_xor(ss, 1); ss += __shfl_xor(ss, 2); ss += __shfl_xor(ss, 4);
    const float rstd = 1.f / sqrtf(ss * (1.f / 128.f) + EPS);
    float y[16];
#pragma unroll
    for (int k = 0; k < 16; ++k) y[k] = hs[k] * rstd * hnorm[c0 + k] * (1.f / (1.f + __expf(-og[k])));
    u32x4 w0, w1; w0.x = pk2(y[0], y[1]); w0.y = pk2(y[2], y[3]); w0.z = pk2(y[4], y[5]); w0.w = pk2(y[6], y[7]);
    w1.x = pk2(y[8], y[9]); w1.y = pk2(y[10], y[11]); w1.z = pk2(y[12], y[13]); w1.w = pk2(y[14], y[15]);
    *(u32x4*)(Obuf + (size_t)row * DM + c0) = w0; *(u32x4*)(Obuf + (size_t)row * DM + c0 + 8) = w1;
}
DI void p0_phase(const Params& P, LAS char* lds) {
    int tid_ = threadIdx.x; asm volatile("" : "+v"(tid_)); const int tid = tid_;
    float* mods = (float*)(P.ws + WS_MODS); float* rope = (float*)(P.ws + WS_ROPE); float* hc = (float*)(P.ws + WS_HC);
    const float* c = P.in[1]; const float* cctx = P.in[3]; const float* ada_w = P.in[4]; const float* ada_b = P.in[5];
    { const size_t gt = (size_t)blockIdx.x * NTHREADS + tid, gs = (size_t)gridDim.x * NTHREADS;
      const f32x4* xs = (const f32x4*)P.in[0]; f32x4* xd = (f32x4*)P.out;
      for (size_t i = gt; i < (size_t)MLAT * DM / 4; i += gs) xd[i] = xs[i];
      const f32x4* cs = (const f32x4*)P.in[2]; f32x4* cd = (f32x4*)hc;
      for (size_t i = gt; i < (size_t)MCTX * DM / 4; i += gs) cd[i] = cs[i];
      for (size_t i = gt; i < (size_t)SEQ * 32; i += gs) { const int t = (int)(i >> 5), j = (int)(i & 31);
          const float pos = (float)((j < 16) ? (t >> 6) : (t & 63)); const float inv = powf(10000.0f, -(float)(j & 15) / 16.0f); const float ang = pos * inv;
          rope[2 * i] = cosf(ang); rope[2 * i + 1] = sinf(ang); } }
    LAS float* sc = (LAS float*)lds;
    LAS float* part = sc + 9 * 1024;
    for (int i = tid; i < 9 * 1024; i += NTHREADS) { const int idx = i >> 10, k = i & 1023; const float v = idx < 8 ? c[idx * 1024 + k] : cctx[k]; sc[i] = v / (1.f + expf(-v)); }
    __syncthreads();
    for (int item = blockIdx.x; item < 4 * 48; item += gridDim.x) {
        const int l = item / 48, cb = item % 48, col = tid & 127, kq = tid >> 7;
        const float* W = ada_w + (size_t)l * 1024 * 6144 + cb * 128 + col;
        float acc[9];
#pragma unroll
        for (int i = 0; i < 9; ++i) acc[i] = 0.f;
#pragma unroll 8
        for (int k = kq * 256; k < kq * 256 + 256; ++k) { const float wv = W[(size_t)k * 6144];
#pragma unroll
            for (int i = 0; i < 9; ++i) acc[i] += sc[i * 1024 + k] * wv; }
#pragma unroll
        for (int i = 0; i < 9; ++i) part[(kq * 9 + i) * 128 + col] = acc[i];
        __syncthreads();
        for (int o = tid; o < 9 * 128; o += NTHREADS) { const int i = o >> 7, cc = o & 127;
            const float s = (part[(0 * 9 + i) * 128 + cc] + part[(1 * 9 + i) * 128 + cc]) + (part[(2 * 9 + i) * 128 + cc] + part[(3 * 9 + i) * 128 + cc]) + ada_b[l * 6144 + cb * 128 + cc];
            mods[(size_t)(l * 9 + i) * 6144 + cb * 128 + cc] = s; }
        __syncthreads();
    }
}

__global__ void __launch_bounds__(NTHREADS, 2) mega(Params P) {
    extern __shared__ __attribute__((aligned(16))) unsigned char lds_raw[];
    LAS char* lds = (LAS char*)lds_raw;
    cg::grid_group grid = cg::this_grid();
#define THIN_IDS int tid_ = threadIdx.x; asm volatile("" : "+v"(tid_)); const int lane = tid_ & 63, wave = __builtin_amdgcn_readfirstlane(tid_ >> 6); const int gw = blockIdx.x * 8 + wave, NGW = gridDim.x * 8;
    const int lo = P.ph_lo, hi = P.ph_hi;
    int ph = 0;
#define RUN(k) ((k) >= lo && (k) < hi)
#define SEAM(k) do { if ((k) >= lo && (k) + 1 < hi) { if ((k) == 0) { grid.sync(); bar = xcd_barrier_post((unsigned*)(ws + WS_BARW), (volatile LAS unsigned*)(lds + LDS_BYTES - 64)); } else xcd_barrier(bar); } } while (0)
    unsigned char* ws = P.ws;
    float* mods = (float*)(ws + WS_MODS); const float* rope = (const float*)(ws + WS_ROPE); float* hc = (float*)(ws + WS_HC);
    bf16_t* Win = (bf16_t*)(ws + WS_WIN); bf16_t* Wout = (bf16_t*)(ws + WS_WOUT); bf16_t* W1 = (bf16_t*)(ws + WS_W1); bf16_t* W2 = (bf16_t*)(ws + WS_W2);
    bf16_t* Abuf = (bf16_t*)(ws + WS_ABUF); bf16_t* BIG = (bf16_t*)(ws + WS_BIG); bf16_t* HF = (bf16_t*)(ws + WS_HF); bf16_t* HB = (bf16_t*)(ws + WS_HB);
    float* hlat = P.out;
    XcdBarrier bar; bar.bar = (unsigned*)(ws + WS_BARW); bar.x = 0; bar.st = (volatile LAS unsigned*)(lds + LDS_BYTES - 64);
    if (threadIdx.x < 16) ((volatile LAS unsigned*)(lds + LDS_BYTES - 64))[threadIdx.x] = 0u;
    if (blockIdx.x == 0 && lo == 0) for (int i = threadIdx.x; i < XCD_BAR_WORDS; i += NTHREADS) ((unsigned*)(ws + WS_BARW))[i] = 0u;
    __syncthreads();

    #ifndef REP_P0
#define REP_P0 1
#endif
#ifndef REP_G24
#define REP_G24 1
#endif
#ifndef REP_N1
#define REP_N1 1
#endif
#ifndef REP_N2
#define REP_N2 1
#endif
#ifndef REP_G1
#define REP_G1 1
#endif
#ifndef REP_G3
#define REP_G3 1
#endif
#ifdef EXTRA_SYNCS
    if (hi - lo > 1) for (int q = 0; q < EXTRA_SYNCS; ++q) grid.sync();
#endif
    if (RUN(ph)) for (int rep = 0; rep < REP_P0; ++rep) { p0_phase(P, lds); __syncthreads(); }
    SEAM(ph); ++ph;

#pragma unroll 1
    for (int l = 0; l < DEPTH; ++l) {
        const int kind = l % 3, slot = l / 3;
        const bool need_ctx = l < DEPTH - 1;
        const int Mrows = need_ctx ? MTOT : MLAT;
        const int Nin = kind == 0 ? NIN_A : (kind == 1 ? NIN_B : NIN_C);
        const float* modl = mods + (size_t)l * 9 * 6144;
        if (RUN(ph)) for (int rep = 0; rep < REP_N1; ++rep) {
            THIN_IDS
            LAS float* scr = (LAS float*)(lds + wave * 16384);
            ConvDesc cin, cout, c1, c2;
            if (kind == 0) cin = ConvDesc{P.in[10] + (size_t)slot * 1024 * 3104, Win, 1024, 3104, NIN_A, 0, 512, 1024};
            else if (kind == 1) cin = ConvDesc{P.in[14], Win, 1024, 1536, NIN_B, 1280, 0, 1024};
            else cin = ConvDesc{P.in[17], Win, 1024, 3072, NIN_C, 2048, 0, 1024};
            const float* wo = kind == 0 ? P.in[13] + (size_t)slot * 1024 * 1024 : (kind == 1 ? P.in[16] : P.in[23]);
            cout = ConvDesc{wo, Wout, 1024, 1024, 1024, 0, 0, 0};
            c1 = ConvDesc{P.in[8] + (size_t)l * 1024 * 4096, W1, 1024, 4096, 4096, 0, 0, 0};
            c2 = ConvDesc{P.in[9] + (size_t)l * 4096 * 1024, W2, 4096, 1024, 1024, 0, 0, 0};
            const int n_in = 16 * (Nin / 32), n_out = 16 * 32, n_1 = 16 * 128, n_2 = 64 * 32;
            for (int it = gw; it < n_in + n_out + n_1 + n_2; it += NGW) {
                int rr = it;
                if (rr < n_in) { conv_item(cin, scr, rr, lane); continue; } rr -= n_in;
                if (rr < n_out) { conv_item(cout, scr, rr, lane); continue; } rr -= n_out;
                if (rr < n_1) { conv_item(c1, scr, rr, lane); continue; } rr -= n_1;
                conv_item(c2, scr, rr, lane);
            }
            const float* gn = P.in[6] + l * DM;
            for (int row = gw; row < MTOT; row += NGW) {
                const int idx = row < MLAT ? (row >> 11) : 8;
                const float* hrow = row < MLAT ? hlat + (size_t)row * DM : hc + (size_t)(row - MLAT) * DM;
                norm_row(hrow, gn, modl + idx * 6144 + 0 * 1024, modl + idx * 6144 + 1 * 1024, Abuf + (size_t)row * DM, lane);
            }
        }
        SEAM(ph); ++ph;
        if (RUN(ph)) for (int rep = 0; rep < REP_G1; ++rep) {
            pg8::Gemm g{Abuf, Win, MTOT, Nin, DM}; pg8::StaticOrder S; S.init(MTOT, Nin, gridDim.x, blockIdx.x);
            EpiQKV E{BIG, Nin, kind == 0 ? 0 : (kind == 1 ? 1280 : 2048), rope};
#ifndef DIS_G1
            pg8::gemm_phase<EpiQKV, pg8::StaticOrder, true, true>((LAS unsigned char*)lds, g, S, E);
#endif
        }
        SEAM(ph); ++ph;
        if (RUN(ph)) {
            if (kind == 0) {
#ifndef DIS_ML
                mlstm_scan(lds, BIG, P.in[11] + slot * 32, HF, HB, need_ctx);
#ifdef DBL_ML
                mlstm_scan(lds, BIG, P.in[11] + slot * 32, HF, HB, need_ctx);
#endif
#endif
            } else if (kind == 1) {
#ifndef DIS_SWA
                swa_phase(lds, BIG, Abuf, P.in[15], need_ctx);
#ifdef DBL_SWA
                swa_phase(lds, BIG, Abuf, P.in[15], need_ctx);
#endif
#endif
            }
            else {
                float s1 = 0.f, s2 = 0.f;
                for (int i = 0; i < 64; ++i) { s1 += P.in[18][i] * P.in[19][i]; s2 += P.in[20][i] * P.in[21][i]; }
                const float lam_init = 0.47071301834358416f;
                const float lam = expf(s1) - expf(s2) + lam_init;
#ifndef DIS_DIFF
                diff_phase(lds, BIG, Abuf, P.in[22], lam, 1.f - lam_init, need_ctx);
#ifdef DBL_DIFF
                diff_phase(lds, BIG, Abuf, P.in[22], lam, 1.f - lam_init, need_ctx);
#endif
#endif
            }
        }
        SEAM(ph); ++ph;
        if (kind == 0) {
            if (RUN(ph)) {
                THIN_IDS
                const float* hn = P.in[12] + slot * 1024;
                for (int row = gw; row < Mrows; row += NGW) mlstm_finish_row(HF, HB, BIG, hn, Abuf, row, lane);
            }
            SEAM(ph);
        }
        ++ph;
        if (RUN(ph)) for (int rep = 0; rep < REP_G24; ++rep) {
            pg8::Gemm g{Abuf, Wout, Mrows, DM, DM}; pg8::StaticOrder S; S.init(Mrows, DM, gridDim.x, blockIdx.x);
            EpiResid E{hlat, hc, modl + 2 * 1024, 1.f / REP_G24};
#ifndef DIS_G2
            pg8::gemm_phase<EpiResid, pg8::StaticOrder, true, true>((LAS unsigned char*)lds, g, S, E);
#endif
        }
        SEAM(ph); ++ph;
        if (RUN(ph)) for (int rep = 0; rep < REP_N2; ++rep) {
            THIN_IDS
            const float* gn = P.in[7] + l * DM;
            for (int row = gw; row < Mrows; row += NGW) {
                const int idx = row < MLAT ? (row >> 11) : 8;
                const float* hrow = row < MLAT ? hlat + (size_t)row * DM : hc + (size_t)(row - MLAT) * DM;
                norm_row(hrow, gn, modl + idx * 6144 + 3 * 1024, modl + idx * 6144 + 4 * 1024, Abuf + (size_t)row * DM, lane);
            }
        }
        SEAM(ph); ++ph;
        if (RUN(ph)) for (int rep = 0; rep < REP_G3; ++rep) {
            pg8::Gemm g{Abuf, W1, Mrows, DFF, DM}; pg8::StaticOrder S; S.init(Mrows, DFF, gridDim.x, blockIdx.x);
            EpiSqRelu E{BIG, DFF};
#ifndef DIS_G3
            pg8::gemm_phase<EpiSqRelu, pg8::StaticOrder, true, true>((LAS unsigned char*)lds, g, S, E);
#endif
        }
        SEAM(ph); ++ph;
        if (RUN(ph)) for (int rep = 0; rep < REP_G24; ++rep) {
            pg8::Gemm g{BIG, W2, Mrows, DM, DFF}; pg8::StaticOrder S; S.init(Mrows, DM, gridDim.x, blockIdx.x);
            EpiResid E{hlat, hc, modl + 5 * 1024, 1.f / REP_G24};
#ifndef DIS_G4
            pg8::gemm_phase<EpiResid, pg8::StaticOrder, true, true>((LAS unsigned char*)lds, g, S, E);
#endif
        }
        SEAM(ph); ++ph;
    }
    if (RUN(ph)) {
        THIN_IDS
        for (int row = gw; row < MLAT; row += NGW) {
            float* hrow = hlat + (size_t)row * DM;
            const f32x4* xr = (const f32x4*)hrow + lane;
            f32x4 v[4]; float s = 0.f;
#pragma unroll
            for (int j = 0; j < 4; ++j) { v[j] = xr[64 * j]; s += (v[j][0] * v[j][0] + v[j][1] * v[j][1]) + (v[j][2] * v[j][2] + v[j][3] * v[j][3]); }
            const float rstd = 1.f / sqrtf(wave_sum(s) * (1.f / DM) + EPS);
#pragma unroll
            for (int j = 0; j < 4; ++j) { const f32x4 gg = ((const f32x4*)P.in[24])[lane + 64 * j]; ((f32x4*)hrow)[lane + 64 * j] = v[j] * rstd * gg; }
        }
    }
#undef RUN
#undef SEAM
}
constexpr int N_PHASES = 1 + 8 * DEPTH + 1;

#ifndef MK_MULTI
#define MK_MULTI 0
#endif
extern "C" void kernel_launch(void* const* d_in, const int* in_sizes, int n_in, void* d_out, int out_size, void* d_ws, size_t ws_size, hipStream_t stream) {
    static int grid = 0;
    if (grid == 0) {
        if (n_in != 25 || ws_size < WS_END) { fprintf(stderr, "kernel_launch: unexpected n_in %d / ws_size %zu\n", n_in, ws_size); grid = -1; return; }
        int dev = 0, cus = 0, per_cu = 0;
        hipGetDevice(&dev); hipDeviceGetAttribute(&cus, hipDeviceAttributeMultiprocessorCount, dev);
        if (hipFuncSetAttribute((const void*)mega, hipFuncAttributeMaxDynamicSharedMemorySize, LDS_BYTES) != hipSuccess) { fprintf(stderr, "hipFuncSetAttribute failed\n"); grid = -1; return; }
        if (hipOccupancyMaxActiveBlocksPerMultiprocessor(&per_cu, (const void*)mega, NTHREADS, LDS_BYTES) != hipSuccess || per_cu < 1) { fprintf(stderr, "occupancy query: %d\n", per_cu); per_cu = 1; }
        (void)hipGetLastError();
        grid = cus * (per_cu > 1 ? 1 : per_cu);
    }
    if (grid < 0) return;
    Params p{};
    for (int i = 0; i < 25; ++i) p.in[i] = (const float*)d_in[i];
    p.out = (float*)d_out; p.ws = (unsigned char*)d_ws;
#if MK_MULTI
    for (int k = 0; k < N_PHASES; ++k) { p.ph_lo = k; p.ph_hi = k + 1; hipLaunchKernelGGL(mega, dim3(grid), dim3(NTHREADS), LDS_BYTES, stream, p); }
#else
    p.ph_lo = 0; p.ph_hi = N_PHASES;
    void* args[] = {&p};
    hipError_t e = hipLaunchCooperativeKernel((const void*)mega, dim3(grid), dim3(NTHREADS), args, LDS_BYTES, stream);
    if (e != hipSuccess) fprintf(stderr, "cooperative launch failed: %s (grid %d)\n", hipGetErrorString(e), grid);
#endif
}
```

```cpp
#include <hip/hip_runtime.h>
#include <hip/hip_cooperative_groups.h>
#include <cstdio>
#include <cstdint>
namespace cg = cooperative_groups;
namespace pg8 {
#define PG8_LAS __attribute__((address_space(3)))
typedef unsigned short bf16_t;
typedef short bf16x8 __attribute__((ext_vector_type(8)));
typedef float f32x4 __attribute__((ext_vector_type(4)));
typedef unsigned u32x4 __attribute__((ext_vector_type(4)));
constexpr int BM = 256, BK = 64, HALF = 128, HTB = HALF * BK * 2  , STAGE_BYTES = 8 * HTB, NXCD = 8, WGM = 8;

__host__ __device__ __forceinline__ int lds_byte(int r, int c) { const int st = (r >> 4) * 2 + (c >> 5), rr = r & 15, cc = c & 31, ob = rr * 64 + cc * 2; return st * 1024 + (ob ^ (((ob >> 9) & 1) << 5)); }
__host__ __device__ __forceinline__ void stage_rc(int b, int& R, int& C) { const int st = b / 1024, sb = b % 1024, swz = sb ^ (((sb >> 9) & 1) << 5); R = (st >> 1) * 16 + swz / 64; C = (st & 1) * 32 + (swz % 64) / 2; }
__host__ __device__ __forceinline__ int perm32(int rho) { const int n = rho >> 4, i = rho & 15; return 8 * (i >> 2) + 4 * n + (i & 3); }

struct Unit { int pm, pn, pk; };
struct Gemm { const bf16_t* A; const bf16_t* Bt; int M, N, K, ldk; };

struct StaticOrder {
    int nM, nN, nwg, G, c;
    __host__ __device__ void init(int M, int N, int G_, int c_) { nM = M / BM; nN = N / BM; nwg = nM * nN; G = G_; c = c_; }
    __host__ __device__ bool next(int i, Unit& u) const {
        const long L = (long)i * G + c; if (L >= nwg) return false;
        int wgid = (int)L; { const int q = nwg / NXCD, r = nwg % NXCD, xcd = wgid % NXCD, off = wgid / NXCD; wgid = (xcd < r ? xcd * (q + 1) : r * (q + 1) + (xcd - r) * q) + off; }
        const int nig = WGM * nN, gid = wgid / nig, fm = gid * WGM, gsz = (nM - fm) < WGM ? (nM - fm) : WGM;
        u.pm = fm + ((wgid % nig) % gsz); u.pn = (wgid % nig) / gsz; u.pk = 0; return true;
    }
    __device__ __forceinline__ void a_ready(const Unit&) const {}
    __device__ __forceinline__ void done(const Unit&) const {}
};

struct SplitOrder {
    int nM, nN, nS, nwg, G, c;
    __host__ __device__ void init(int M, int N, int nS_, int G_, int c_) { nM = M / BM; nN = N / BM; nS = nS_; nwg = nM * nN * nS; G = G_; c = c_; }
    __host__ __device__ bool next(int i, Unit& u) const {
        const long L = (long)i * G + c; if (L >= nwg) return false;
        const int w = (int)L; u.pk = w % nS; const int t = w / nS; u.pn = t % nN; u.pm = t / nN; return true;
    }
    __device__ __forceinline__ void a_ready(const Unit&) const {}
    __device__ __forceinline__ void done(const Unit&) const {}
};

__device__ __forceinline__ unsigned cvt_pk_bf16(float lo, float hi) { unsigned r; asm volatile("v_cvt_pk_bf16_f32 %0, %1, %2" : "=v"(r) : "v"(lo), "v"(hi)); return r; }
template <class Epi, class Sched, bool ALIGN_EPI = false, bool SP2 = false>
__device__ __forceinline__ void gemm_phase(PG8_LAS unsigned char* lds, const Gemm g, const Sched& S, const Epi& E) {
    int tid_o = threadIdx.x; asm volatile("" : "+v"(tid_o)); const int tid = tid_o, wid = __builtin_amdgcn_readfirstlane(tid >> 6), lane = tid & 63, wr = wid >> 2, wc = wid & 3, fr = lane & 15, fq = lane >> 4;
    const int K = g.K, nt = K / BK, LDK = g.ldk;
    unsigned voffA[2], voffB[2];
#pragma unroll
    for (int i = 0; i < 2; ++i) { int R, C; stage_rc(tid * 16 + i * 8192, R, C); const int Rb = Epi::PERM ? ((R & ~31) + perm32(R & 31)) : R;
        voffA[i] = (unsigned)(R * LDK + C) * 2u; voffB[i] = (unsigned)(Rb * LDK + C) * 2u; }
    const size_t kstep = (size_t)(BK * 2);
    const size_t hstep = (size_t)HALF * LDK * 2;
    const size_t tstep = 2 * hstep;
    const unsigned ldsw = (unsigned)wid * 1024u;
    const int aoff = lds_byte(wr * 64 + fr, fq * 8), boff = lds_byte(wc * 32 + fr, fq * 8);
#define PG8_SA(b, h) (((b) * 2 + (h)) * HTB)
#define PG8_SB(b, h) ((4 + (b) * 2 + (h)) * HTB)
#define PG8_STAGE(bufoff, gbase, voff) do { _Pragma("unroll") for (int _i = 0; _i < 2; ++_i) \
        __builtin_amdgcn_global_load_lds((const unsigned*)((const char*)(gbase) + (voff)[_i]), (PG8_LAS unsigned*)(lds + (bufoff) + ldsw + _i * 8192), 16, 0, 0); } while (0)
#define PG8_LDA(dst, b, h) do { _Pragma("unroll") for (int m = 0; m < 4; ++m) _Pragma("unroll") for (int k = 0; k < 2; ++k) dst[m][k] = *(const PG8_LAS bf16x8*)(lds + PG8_SA(b, h) + aoff + m * 2048 + k * 1024); } while (0)
#define PG8_LDB(dst, b, h) do { _Pragma("unroll") for (int n = 0; n < 2; ++n) _Pragma("unroll") for (int k = 0; k < 2; ++k) dst[n][k] = *(const PG8_LAS bf16x8*)(lds + PG8_SB(b, h) + boff + n * 2048 + k * 1024); } while (0)
#define PG8_MMA(ai, bj, At, Bt) do { __builtin_amdgcn_s_setprio(1); _Pragma("unroll") for (int m = 0; m < 4; ++m) _Pragma("unroll") for (int n = 0; n < 2; ++n) _Pragma("unroll") for (int k = 0; k < 2; ++k) \
        acc[ai][bj][m][n] = __builtin_amdgcn_mfma_f32_16x16x32_bf16(Bt[n][k], At[m][k], acc[ai][bj][m][n], 0, 0, 0); __builtin_amdgcn_s_setprio(0); } while (0)
#define PG8_WAIT_V(n) asm volatile("s_waitcnt vmcnt(" #n ")" ::: "memory")
#define PG8_WAIT_L(n) asm volatile("s_waitcnt lgkmcnt(" #n ")" ::: "memory")
#define PG8_BAR __builtin_amdgcn_s_barrier()
#define PG8_SCHED __builtin_amdgcn_sched_barrier(0)
    Unit cur, nxt; int ui = 0;
    if (!S.next(0, cur)) return;
    f32x4 acc[2][2][4][2];
#pragma unroll
    for (int a = 0; a < 2; ++a)
#pragma unroll
        for (int b = 0; b < 2; ++b)
#pragma unroll
            for (int m = 0; m < 4; ++m)
#pragma unroll
                for (int n = 0; n < 2; ++n) acc[a][b][m][n] = (f32x4){0.f, 0.f, 0.f, 0.f};
    bf16x8 At[4][2], B0[2][2], B1[2][2];
    const char* cA = (const char*)g.A + (size_t)cur.pm * tstep + (size_t)cur.pk * K * 2; const char* cB = (const char*)g.Bt + (size_t)cur.pn * tstep + (size_t)cur.pk * K * 2;
    S.a_ready(cur);
    if constexpr (SP2) {
        PG8_STAGE(PG8_SB(0, 0), cB, voffB); PG8_STAGE(PG8_SB(0, 1), cB + hstep, voffB); PG8_STAGE(PG8_SA(0, 0), cA, voffA); PG8_STAGE(PG8_SA(0, 1), cA + hstep, voffA);
        if (wr == 1) PG8_BAR;
        PG8_WAIT_V(2); PG8_BAR;
        PG8_STAGE(PG8_SB(1, 0), cB + kstep, voffB); PG8_STAGE(PG8_SA(1, 0), cA + kstep, voffA); PG8_STAGE(PG8_SB(1, 1), cB + hstep + kstep, voffB);
        PG8_WAIT_V(6); PG8_BAR;
    } else {
        PG8_STAGE(PG8_SB(0, 0), cB, voffB); PG8_STAGE(PG8_SA(0, 0), cA, voffA); PG8_STAGE(PG8_SB(0, 1), cB + hstep, voffB); PG8_STAGE(PG8_SA(0, 1), cA + hstep, voffA);
        if (wr == 1) PG8_BAR;
        PG8_WAIT_V(4); PG8_BAR;
        PG8_STAGE(PG8_SB(1, 0), cB + kstep, voffB); PG8_STAGE(PG8_SA(1, 0), cA + kstep, voffA); PG8_STAGE(PG8_SB(1, 1), cB + hstep + kstep, voffB);
        PG8_WAIT_V(6); PG8_BAR;
    }
    for (;;) {
        const bool has_next = S.next(ui + 1, nxt);
        const char* nA = has_next ? (const char*)g.A + (size_t)nxt.pm * tstep + (size_t)nxt.pk * K * 2 : cA; const char* nB = has_next ? (const char*)g.Bt + (size_t)nxt.pn * tstep + (size_t)nxt.pk * K * 2 : cB;
        for (int t = 0; t < nt; t += 2) {
            const bool last = (t == nt - 2);
            const char* a1 = cA + (size_t)(t + 1) * kstep;
            const char* a2 = last ? nA : cA + (size_t)(t + 2) * kstep; const char* b2 = last ? nB : cB + (size_t)(t + 2) * kstep;
            const char* a3 = a2 + kstep; const char* b3 = b2 + kstep;
            if (last && has_next) S.a_ready(nxt);
            if constexpr (SP2) {
            PG8_LDB(B0, 0, 0); PG8_LDB(B1, 0, 1); PG8_SCHED; PG8_LDA(At, 0, 0); PG8_STAGE(PG8_SA(1, 1), a1 + hstep, voffA);
            PG8_WAIT_V(8); PG8_WAIT_L(0); PG8_BAR; PG8_MMA(0, 0, At, B0); PG8_MMA(0, 1, At, B1); PG8_BAR; PG8_SCHED;
            PG8_LDA(At, 0, 1); PG8_STAGE(PG8_SB(0, 0), b2, voffB); PG8_STAGE(PG8_SB(0, 1), b2 + hstep, voffB); PG8_STAGE(PG8_SA(0, 0), a2, voffA);
            PG8_WAIT_V(8); PG8_WAIT_L(0); PG8_BAR; PG8_MMA(1, 0, At, B0); PG8_MMA(1, 1, At, B1); PG8_BAR; PG8_SCHED;
            PG8_LDB(B0, 1, 0); PG8_LDB(B1, 1, 1); PG8_SCHED; PG8_LDA(At, 1, 0); PG8_STAGE(PG8_SA(0, 1), a2 + hstep, voffA);
            PG8_WAIT_V(8); PG8_WAIT_L(0); PG8_BAR; PG8_MMA(0, 0, At, B0); PG8_MMA(0, 1, At, B1); PG8_BAR; PG8_SCHED;
            PG8_LDA(At, 1, 1); PG8_STAGE(PG8_SB(1, 0), b3, voffB); PG8_STAGE(PG8_SB(1, 1), b3 + hstep, voffB); PG8_STAGE(PG8_SA(1, 0), a3, voffA);
            PG8_WAIT_V(8); PG8_WAIT_L(0); PG8_BAR; PG8_MMA(1, 0, At, B0); PG8_MMA(1, 1, At, B1); PG8_BAR; PG8_SCHED;
            } else {
            PG8_LDB(B0, 0, 0); PG8_SCHED; PG8_LDA(At, 0, 0); PG8_STAGE(PG8_SA(1, 1), a1 + hstep, voffA);
            PG8_WAIT_L(8); PG8_BAR; PG8_WAIT_L(0); PG8_MMA(0, 0, At, B0); PG8_BAR; PG8_SCHED;
            PG8_LDB(B1, 0, 1); PG8_STAGE(PG8_SB(0, 0), b2, voffB);
            PG8_BAR; PG8_WAIT_L(0); PG8_MMA(0, 1, At, B1); PG8_BAR;
            PG8_LDA(At, 0, 1); PG8_STAGE(PG8_SA(0, 0), a2, voffA);
            PG8_BAR; PG8_WAIT_L(0); PG8_MMA(1, 0, At, B0); PG8_BAR; PG8_SCHED;
            PG8_STAGE(PG8_SB(0, 1), b2 + hstep, voffB);
            PG8_WAIT_V(6); PG8_BAR; PG8_MMA(1, 1, At, B1); PG8_BAR;
            PG8_LDB(B0, 1, 0); PG8_SCHED; PG8_LDA(At, 1, 0); PG8_STAGE(PG8_SA(0, 1), a2 + hstep, voffA);
            PG8_WAIT_L(8); PG8_BAR; PG8_WAIT_L(0); PG8_MMA(0, 0, At, B0); PG8_BAR; PG8_SCHED;
            PG8_LDB(B1, 1, 1); PG8_STAGE(PG8_SB(1, 0), b3, voffB);
            PG8_BAR; PG8_WAIT_L(0); PG8_MMA(0, 1, At, B1); PG8_BAR;
            PG8_LDA(At, 1, 1); PG8_STAGE(PG8_SA(1, 0), a3, voffA);
            PG8_BAR; PG8_WAIT_L(0); PG8_MMA(1, 0, At, B0); PG8_BAR; PG8_SCHED;
            PG8_STAGE(PG8_SB(1, 1), b3 + hstep, voffB);
            PG8_WAIT_V(6); PG8_BAR; PG8_MMA(1, 1, At, B1); PG8_BAR;
            }
        }
        if constexpr (ALIGN_EPI) { if (wr == 0) PG8_BAR; }
        if constexpr (!Epi::AFTER_DRAIN) { E(acc, cur, wr, wc, fr, fq); S.done(cur); }
        if (!has_next) break;
#pragma unroll
        for (int a = 0; a < 2; ++a)
#pragma unroll
            for (int b = 0; b < 2; ++b)
#pragma unroll
                for (int m = 0; m < 4; ++m)
#pragma unroll
                    for (int n = 0; n < 2; ++n) acc[a][b][m][n] = (f32x4){0.f, 0.f, 0.f, 0.f};
        cur = nxt; cA = nA; cB = nB; ++ui;
        if constexpr (ALIGN_EPI) { if (wr == 1) PG8_BAR; }
    }
    PG8_WAIT_V(0);
    if constexpr (!ALIGN_EPI) { if (wr == 0) PG8_BAR; }
    PG8_BAR;
    if constexpr (Epi::AFTER_DRAIN) { E.fused(acc, cur, wr, wc, fr, fq, lds, wid, lane); S.done(cur); }
#undef PG8_SA
#undef PG8_SB
#undef PG8_STAGE
#undef PG8_LDA
#undef PG8_LDB
#undef PG8_MMA
#undef PG8_WAIT_V
#undef PG8_WAIT_L
#undef PG8_BAR
#undef PG8_SCHED
}
}
using pg8::bf16_t; using pg8::bf16x8; using pg8::f32x4; using pg8::u32x4;
#define LAS __attribute__((address_space(3)))
#define DI __device__ __forceinline__
typedef short s16x4 __attribute__((ext_vector_type(4)));
typedef short v4i16_t __attribute__((ext_vector_type(4)));
typedef float f32x16 __attribute__((ext_vector_type(16)));
typedef float f32x2_t __attribute__((ext_vector_type(2)));
typedef __bf16 bf16x2_t __attribute__((ext_vector_type(2)));
typedef unsigned u32x2 __attribute__((ext_vector_type(2)));
#define MFMA32(a, b, c) __builtin_amdgcn_mfma_f32_32x32x16_bf16((a), (b), (c), 0, 0, 0)

constexpr int DM = 1024, NB = 8, SEQ = 2048, CTX = 256, DEPTH = 4, DFF = 4096;
constexpr int MLAT = NB * SEQ, MCTX = NB * CTX, MTOT = MLAT + MCTX;
constexpr int NIN_A = 3328, NIN_B = 1536, NIN_C = 3072;
constexpr float EPS = 1e-6f;
constexpr size_t MiB = 1u << 20;
constexpr size_t WS_BARW = 1 * MiB + 768 * 1024;
constexpr size_t WS_MODS = 0, WS_ROPE = 1 * MiB, WS_HC = 2 * MiB, WS_WIN = 10 * MiB, WS_WOUT = 17 * MiB, WS_W1 = 19 * MiB, WS_W2 = 27 * MiB,
                 WS_ABUF = 36 * MiB, WS_BIG = 72 * MiB, WS_HF = 216 * MiB, WS_HB = 252 * MiB, WS_END = 288 * MiB;
constexpr int LDS_BYTES = 147456;
constexpr int NTHREADS = 512;

struct Params { const float* in[25]; float* out; unsigned char* ws; int ph_lo, ph_hi; };

DI unsigned pk2(float lo, float hi) { f32x2_t v = {lo, hi}; bf16x2_t b = __builtin_convertvector(v, bf16x2_t); return __builtin_bit_cast(unsigned, b); }
DI float bflo(unsigned u) { return __uint_as_float(u << 16); }
DI float bfhi(unsigned u) { return __uint_as_float(u & 0xffff0000u); }
DI float bf1(unsigned short u) { return __uint_as_float(((unsigned)u) << 16); }
DI float wave_sum(float v) {
#pragma unroll
    for (int o = 1; o < 64; o <<= 1) v += __shfl_xor(v, o);
    return v;
}
DI int crow(int i, int h) { return (i & 3) + 8 * (i >> 2) + 4 * h; }
DI s16x4 vtr(const LAS char* p) { return __builtin_bit_cast(s16x4, __builtin_amdgcn_ds_read_tr16_b64_v4i16((LAS v4i16_t*)p)); }
DI bf16x8 cat8(s16x4 lo, s16x4 hi) { return __builtin_shufflevector(lo, hi, 0, 1, 2, 3, 4, 5, 6, 7); }
template <int S> DI bf16x8 packP(const f32x16& x) {
    u32x4 p; p.x = pk2(x[8 * S + 0], x[8 * S + 1]); p.y = pk2(x[8 * S + 2], x[8 * S + 3]); p.z = pk2(x[8 * S + 4], x[8 * S + 5]); p.w = pk2(x[8 * S + 6], x[8 * S + 7]);
    return __builtin_bit_cast(bf16x8, p);
}
#define LDS_WAIT() asm volatile("s_waitcnt lgkmcnt(0)" ::: "memory")

struct EpiQKV {
    static constexpr bool PERM = true, AFTER_DRAIN = false;
    bf16_t* O; int ldc; int rope_cols; const float* rope;
    DI void operator()(const f32x4 (&acc)[2][2][4][2], const pg8::Unit& u, int wr, int wc, int fr, int fq) const {
        const int row0 = u.pm * 256 + wr * 64 + fr, col0 = u.pn * 256 + wc * 32 + 8 * fq;
        const bool do_rope = (u.pn * 256 < rope_cols) && (u.pm < 64);
#pragma unroll
        for (int ai = 0; ai < 2; ++ai)
#pragma unroll
            for (int m = 0; m < 4; ++m) {
                const int row = row0 + ai * 128 + m * 16; bf16_t* rowp = O + (size_t)row * ldc + col0; const int t = row & 2047;
#pragma unroll
                for (int bj = 0; bj < 2; ++bj) {
                    f32x4 v0 = acc[ai][bj][m][0], v1 = acc[ai][bj][m][1];
                    if (do_rope) {
                        const int j0 = ((col0 + bj * 128) & 63) >> 1;
                        const f32x4 cs0 = *(const f32x4*)(rope + (size_t)(t * 32 + j0) * 2), cs1 = *(const f32x4*)(rope + (size_t)(t * 32 + j0) * 2 + 4);
                        f32x4 r0, r1;
                        r0[0] = v0[0] * cs0[0] - v0[1] * cs0[1]; r0[1] = v0[0] * cs0[1] + v0[1] * cs0[0];
                        r0[2] = v0[2] * cs0[2] - v0[3] * cs0[3]; r0[3] = v0[2] * cs0[3] + v0[3] * cs0[2];
                        r1[0] = v1[0] * cs1[0] - v1[1] * cs1[1]; r1[1] = v1[0] * cs1[1] + v1[1] * cs1[0];
                        r1[2] = v1[2] * cs1[2] - v1[3] * cs1[3]; r1[3] = v1[2] * cs1[3] + v1[3] * cs1[2];
                        v0 = r0; v1 = r1;
                    }
                    u32x4 w; w.x = pk2(v0[0], v0[1]); w.y = pk2(v0[2], v0[3]); w.z = pk2(v1[0], v1[1]); w.w = pk2(v1[2], v1[3]);
                    *(u32x4*)(rowp + bj * 128) = w;
                }
            }
    }
};
struct EpiSqRelu {
    static constexpr bool PERM = true, AFTER_DRAIN = false;
    bf16_t* O; int ldc;
    DI void operator()(const f32x4 (&acc)[2][2][4][2], const pg8::Unit& u, int wr, int wc, int fr, int fq) const {
        const int row0 = u.pm * 256 + wr * 64 + fr, col0 = u.pn * 256 + wc * 32 + 8 * fq;
#pragma unroll
        for (int ai = 0; ai < 2; ++ai)
#pragma unroll
            for (int m = 0; m < 4; ++m) {
                bf16_t* rowp = O + (size_t)(row0 + ai * 128 + m * 16) * ldc + col0;
#pragma unroll
                for (int bj = 0; bj < 2; ++bj) {
                    f32x4 v0 = acc[ai][bj][m][0], v1 = acc[ai][bj][m][1];
#pragma unroll
                    for (int e = 0; e < 4; ++e) { float a = fmaxf(v0[e], 0.f), b = fmaxf(v1[e], 0.f); v0[e] = a * a; v1[e] = b * b; }
                    u32x4 w; w.x = pk2(v0[0], v0[1]); w.y = pk2(v0[2], v0[3]); w.z = pk2(v1[0], v1[1]); w.w = pk2(v1[2], v1[3]);
                    *(u32x4*)(rowp + bj * 128) = w;
                }
            }
    }
};
struct EpiResid {
    static constexpr bool PERM = true, AFTER_DRAIN = false;
    float* hlat; float* hctx; const float* gate_base; float gscale;
    DI void operator()(const f32x4 (&acc)[2][2][4][2], const pg8::Unit& u, int wr, int wc, int fr, int fq) const {
        const int idx = u.pm < 64 ? (u.pm >> 3) : 8;
        float* hb = u.pm < 64 ? hlat + (size_t)u.pm * 256 * DM : hctx + (size_t)(u.pm - 64) * 256 * DM;
        const int col0 = u.pn * 256 + wc * 32 + 8 * fq;
        const float* gp = gate_base + idx * 6144 + col0;
        float* rowp0 = hb + (size_t)(wr * 64 + fr) * DM + col0;
#pragma unroll
        for (int bj = 0; bj < 2; ++bj)
#pragma unroll
            for (int n = 0; n < 2; ++n) {
                const f32x4 g = *(const f32x4*)(gp + bj * 128 + 4 * n) * gscale;
#pragma unroll
                for (int ai = 0; ai < 2; ++ai)
#pragma unroll
                    for (int m = 0; m < 4; ++m) {
                        float* p = rowp0 + (size_t)(ai * 128 + m * 16) * DM + bj * 128 + 4 * n;
                        f32x4 h0 = *(f32x4*)p; h0 = h0 + g * acc[ai][bj][m][n]; *(f32x4*)p = h0;
                    }
            }
    }
};

struct EpiPartial {
    static constexpr bool PERM = true, AFTER_DRAIN = false;
    float* part; int rows;
    DI void operator()(const f32x4 (&acc)[2][2][4][2], const pg8::Unit& u, int wr, int wc, int fr, int fq) const {
        float* base = part + ((size_t)u.pk * rows + u.pm * 256 + wr * 64 + fr) * DM + u.pn * 256 + wc * 32 + 8 * fq;
#pragma unroll
        for (int ai = 0; ai < 2; ++ai)
#pragma unroll
            for (int m = 0; m < 4; ++m)
#pragma unroll
                for (int bj = 0; bj < 2; ++bj) { float* p = base + (size_t)(ai * 128 + m * 16) * DM + bj * 128; *(f32x4*)p = acc[ai][bj][m][0]; *(f32x4*)(p + 4) = acc[ai][bj][m][1]; }
    }
};

DI void norm_row(float* hrow, const float* g, const float* shift, const float* scale, bf16_t* orow, int lane, const float* part, int nsplit, size_t pstride, const float* pgate) {
    const f32x4* xr = (const f32x4*)hrow + lane;
    f32x4 v[4]; float s = 0.f;
#pragma unroll
    for (int j = 0; j < 4; ++j) v[j] = xr[64 * j];
    if (part) {
#pragma unroll
        for (int j = 0; j < 4; ++j) { f32x4 a = ((const f32x4*)part)[lane + 64 * j];
            for (int q = 1; q < nsplit; ++q) a = a + ((const f32x4*)(part + q * pstride))[lane + 64 * j];
            v[j] = v[j] + ((const f32x4*)pgate)[lane + 64 * j] * a; ((f32x4*)hrow)[lane + 64 * j] = v[j]; }
    }
#pragma unroll
    for (int j = 0; j < 4; ++j) s += (v[j][0] * v[j][0] + v[j][1] * v[j][1]) + (v[j][2] * v[j][2] + v[j][3] * v[j][3]);
    const float rstd = 1.f / sqrtf(wave_sum(s) * (1.f / DM) + EPS);
    u32x2* o8 = (u32x2*)orow + lane;
#pragma unroll
    for (int j = 0; j < 4; ++j) {
        const f32x4 gg = ((const f32x4*)g)[lane + 64 * j];
        f32x4 y = v[j] * rstd * gg;
        const f32x4 sh = ((const f32x4*)shift)[lane + 64 * j], sc = ((const f32x4*)scale)[lane + 64 * j]; y = y * (sc + 1.f) + sh;
        u32x2 w; w.x = pk2(y[0], y[1]); w.y = pk2(y[2], y[3]); o8[64 * j] = w;
    }
}
struct ConvDesc { const float* W; bf16_t* WT; int K, Nsrc, Ndst, rope_cols, sc_lo, sc_hi; };
DI void conv_item(const ConvDesc& d, LAS float* scr, int item, int lane) {
    const int nblk = d.Ndst / 32, kb = item / nblk, nb = item % nblk, k0 = 64 * kb, n0 = 32 * nb;
    const int q = lane & 31, nd = n0 + q;
    int ns = nd;
    if (nd < d.rope_cols) { const int head = nd >> 6, p = nd & 63; ns = head * 64 + (p >> 1) + 32 * (p & 1); }
    const bool valid = ns < d.Nsrc;
    const float scl = (nd >= d.sc_lo && nd < d.sc_hi) ? 0.125f : 1.f;
    const float* src = d.W + (size_t)k0 * d.Nsrc + (valid ? ns : 0);
#pragma unroll 8
    for (int i = 0; i < 32; ++i) { const int kk = 2 * i + (lane >> 5); const float w = src[(size_t)kk * d.Nsrc]; scr[kk * 33 + q] = valid ? w * scl : 0.f; }
    LDS_WAIT();
    const int c = lane & 7;
#pragma unroll
    for (int j = 0; j < 4; ++j) {
        const int n = (lane >> 3) + 8 * j; const LAS float* s = scr + (8 * c) * 33 + n;
        u32x4 o; o.x = pk2(s[0 * 33], s[1 * 33]); o.y = pk2(s[2 * 33], s[3 * 33]); o.z = pk2(s[4 * 33], s[5 * 33]); o.w = pk2(s[6 * 33], s[7 * 33]);
        *(u32x4*)(d.WT + (size_t)(n0 + n) * d.K + k0 + 8 * c) = o;
    }
    LDS_WAIT();
}
#define XB_TMO      128
#define XB_XCNT(j)  (256  + 64 * (j))
#define XB_XSUB(j)  (1280 + 64 * (j))
#define XB_XGEN(j)  (2304 + 64 * (j))
#define XB_TOP      3328
#define XB_TOPGEN   3392
#define XCD_BAR_WORDS 3456
#define XB_SPIN_CAP (1u << 18)

__device__ __forceinline__ unsigned xb_ld(unsigned* p)              { return __hip_atomic_load(p, __ATOMIC_RELAXED, __HIP_MEMORY_SCOPE_AGENT); }
__device__ __forceinline__ unsigned xb_add(unsigned* p, unsigned v) { return __hip_atomic_fetch_add(p, v, __ATOMIC_RELAXED, __HIP_MEMORY_SCOPE_AGENT); }
__device__ __forceinline__ unsigned xb_xcc_id() { return (unsigned)__builtin_amdgcn_s_getreg((3 << 11) | 20) & 0xFu; }
#define XB_SPIN(cond, bar) do { unsigned _sp = 0; while (cond) { __builtin_amdgcn_s_sleep(1); \
    if ((++_sp & 255u) == 0u) { if (xb_ld(&(bar)[XB_TMO])) break; if (_sp > XB_SPIN_CAP) { atomicAdd(&(bar)[XB_TMO], 1u); break; } } } } while (0)

struct XcdBarrier {
    unsigned* bar; unsigned x;
    volatile __attribute__((address_space(3))) unsigned* st;
};

__device__ __forceinline__ XcdBarrier xcd_barrier_post(unsigned* bar, volatile __attribute__((address_space(3))) unsigned* st) {
    XcdBarrier b; b.bar = bar; b.x = xb_xcc_id(); b.st = st;
    if (threadIdx.x == 0) (void)xb_add(&bar[XB_XCNT(b.x)], 1u);
    return b;
}
__device__ __forceinline__ void xcd_barrier_complete(unsigned* bar, unsigned x, unsigned& nloc, unsigned& nx) {
    const unsigned G = gridDim.x * gridDim.y * gridDim.z;
    unsigned sum, cnt, mine, sp = 0u;
    for (;;) {
        sum = 0u; cnt = 0u; mine = 0u;
#pragma unroll
        for (unsigned j = 0; j < 16; ++j) { const unsigned c = xb_ld(&bar[XB_XCNT(j)]); sum += c; cnt += (c > 0u) ? 1u : 0u; mine = (j == x) ? c : mine; }
        if (sum == G) break;
        __builtin_amdgcn_s_sleep(1);
        if ((++sp & 255u) == 0u) { if (xb_ld(&bar[XB_TMO])) break; if (sp > XB_SPIN_CAP) { atomicAdd(&bar[XB_TMO], 1u); break; } }
    }
    nloc = mine > 0u ? mine : 1u; nx = cnt > 0u ? cnt : 1u;
}

__device__ __forceinline__ void xcd_barrier(const XcdBarrier& b) {
    asm volatile("s_waitcnt vmcnt(0)" ::: "memory");
    __syncthreads();
    if (threadIdx.x == 0) {
        unsigned* bar = b.bar;
        __builtin_amdgcn_s_waitcnt(0);
        unsigned nloc = b.st[0], nx = b.st[1];
        if (nloc == 0u) { xcd_barrier_complete(bar, b.x, nloc, nx); b.st[0] = nloc; b.st[1] = nx; }
        const unsigned old = xb_add(&bar[XB_XSUB(b.x)], 1u);
        const unsigned gen = old / nloc;
        if (old + 1u == (gen + 1u) * nloc) {
            __builtin_amdgcn_fence(__ATOMIC_RELEASE, "agent");
            asm volatile("s_waitcnt vmcnt(0)" ::: "memory");
            const unsigned og = xb_add(&bar[XB_TOP], 1u);
            const unsigned tg = og / nx;
            if (og + 1u == (tg + 1u) * nx) xb_add(&bar[XB_TOPGEN], 1u);
            else XB_SPIN(xb_ld(&bar[XB_TOPGEN]) == tg, bar);
            __builtin_amdgcn_fence(__ATOMIC_ACQUIRE, "agent");
            xb_add(&bar[XB_XGEN(b.x)], 1u);
            asm volatile("s_waitcnt vmcnt(0)" ::: "memory");
        } else {
            XB_SPIN(xb_ld(&bar[XB_XGEN(b.x)]) == gen, bar);
            __builtin_amdgcn_fence(__ATOMIC_ACQUIRE, "agent");
            asm volatile("s_waitcnt vmcnt(0)" ::: "memory");
        }
    }
    __syncthreads();
}
DI void swa_phase(LAS char* lds, const bf16_t* QKV, bf16_t* Obuf, const float* sink, bool need_ctx) {
    int tid_ = threadIdx.x; asm volatile("" : "+v"(tid_)); const int tid = tid_, lane = tid & 63, w = __builtin_amdgcn_readfirstlane(tid >> 6), r = lane & 31, h = lane >> 5;
    const int g = w >> 1, th = w & 1;
    const int i16 = lane & 15, q4 = i16 >> 2, p4 = i16 & 3, g1 = (lane >> 4) & 1;
    LAS char* Kimg = lds; LAS char* Vimg = lds + 9216;
    const int srow = tid >> 3, piece = tid & 7;
    const int nunits = 1024 + (need_ctx ? 128 : 0);
    for (int u = blockIdx.x; u < nunits; u += gridDim.x) {
        int b, kvh, qrow0, t0 = 0, c_lo = 0, n_lat = 0;
        if (u < 1024) { b = u >> 7; kvh = (u >> 5) & 3; t0 = (u & 31) * 64; qrow0 = b * SEQ + t0;
            c_lo = t0 == 0 ? 2 : (t0 == 64 ? 1 : 0); int c_hi = (2176 - t0) / 64; if (c_hi > 5) c_hi = 5; n_lat = c_hi - c_lo; }
        else { const int v = u - 1024; b = v >> 4; kvh = (v >> 2) & 3; qrow0 = MLAT + b * CTX + (v & 3) * 64; }
        const int n = n_lat + 4;
        const int qrow = qrow0 + 32 * th + r, hq = kvh * 4 + g;
        bf16x8 qf[4];
#pragma unroll
        for (int s = 0; s < 4; ++s) qf[s] = *(const bf16x8*)(QKV + (size_t)qrow * NIN_B + hq * 64 + 16 * s + 8 * h);
        float m = sink[hq], l = (h == 0) ? 1.f : 0.f;
        f32x16 O[2];
#pragma unroll
        for (int i = 0; i < 16; ++i) { O[0][i] = 0.f; O[1][i] = 0.f; }
        u32x4 kreg, vreg;
        { const int base = (0 < n_lat) ? b * SEQ + t0 - 128 + 64 * c_lo : MLAT + b * CTX;
          const bf16_t* gp = QKV + (size_t)(base + srow) * NIN_B + kvh * 64 + piece * 8; kreg = *(const u32x4*)(gp + 1024); vreg = *(const u32x4*)(gp + 1280); }
        for (int i = 0; i < n; ++i) {
            __syncthreads();
            *(LAS u32x4*)(Kimg + srow * 144 + piece * 16) = kreg; *(LAS u32x4*)(Vimg + srow * 144 + piece * 16) = vreg;
            __syncthreads();
            if (i + 1 < n) { const int ii = i + 1; const int base = (ii < n_lat) ? b * SEQ + t0 - 128 + 64 * (c_lo + ii) : MLAT + b * CTX + 64 * (ii - n_lat);
                const bf16_t* gp = QKV + (size_t)(base + srow) * NIN_B + kvh * 64 + piece * 8; kreg = *(const u32x4*)(gp + 1024); vreg = *(const u32x4*)(gp + 1280); }
            const bool masked = i < n_lat; const int kpos0 = t0 - 128 + 64 * (c_lo + i), qp = t0 + 32 * th + r;
#pragma unroll
            for (int tile = 0; tile < 2; ++tile) {
                f32x16 S;
#pragma unroll
                for (int e = 0; e < 16; ++e) S[e] = 0.f;
#pragma unroll
                for (int s = 0; s < 4; ++s) { const bf16x8 kf = *(const LAS bf16x8*)(Kimg + (32 * tile + r) * 144 + (16 * s + 8 * h) * 2); S = MFMA32(kf, qf[s], S); }
                if (masked) {
#pragma unroll
                    for (int e = 0; e < 16; ++e) { const int d = kpos0 + 32 * tile + crow(e, h) - qp; if (d > 128 || d < -128) S[e] = -INFINITY; }
                }
                float tmax = S[0];
#pragma unroll
                for (int e = 1; e < 16; ++e) tmax = fmaxf(tmax, S[e]);
                tmax = fmaxf(tmax, __shfl_xor(tmax, 32));
                const float mn = fmaxf(m, tmax), alpha = __expf(m - mn); m = mn;
                float ls = 0.f;
#pragma unroll
                for (int e = 0; e < 16; ++e) { S[e] = __expf(S[e] - mn); ls += S[e]; }
                l = l * alpha + ls;
#pragma unroll
                for (int e = 0; e < 16; ++e) { O[0][e] *= alpha; O[1][e] *= alpha; }
                const bf16x8 pf0 = packP<0>(S), pf1 = packP<1>(S);
#pragma unroll
                for (int blk = 0; blk < 2; ++blk) {
                    const LAS char* vp = Vimg + (32 * tile + 4 * h + q4) * 144 + 2 * (32 * blk + 16 * g1) + 8 * p4;
                    const bf16x8 vf0 = cat8(vtr(vp), vtr(vp + 8 * 144)), vf1 = cat8(vtr(vp + 16 * 144), vtr(vp + 24 * 144));
                    O[blk] = MFMA32(vf0, pf0, O[blk]); O[blk] = MFMA32(vf1, pf1, O[blk]);
                }
            }
        }
        const float inv = 1.f / (l + __shfl_xor(l, 32));
        bf16_t* orow = Obuf + (size_t)qrow * DM + hq * 64 + 4 * h;
#pragma unroll
        for (int blk = 0; blk < 2; ++blk)
#pragma unroll
            for (int ig = 0; ig < 4; ++ig) { u32x2 o; o.x = pk2(O[blk][4 * ig] * inv, O[blk][4 * ig + 1] * inv); o.y = pk2(O[blk][4 * ig + 2] * inv, O[blk][4 * ig + 3] * inv);
                *(u32x2*)(orow + 32 * blk + 8 * ig) = o; }
    }
    __syncthreads();
}

DI void diff_phase(LAS char* lds, const bf16_t* QKV, bf16_t* Obuf, const float* hnorm, float lam, float one_m_lam_init, bool need_ctx) {
    int tid_ = threadIdx.x; asm volatile("" : "+v"(tid_)); const int tid = tid_, lane = tid & 63, w = __builtin_amdgcn_readfirstlane(tid >> 6), r = lane & 31, h = lane >> 5;
    const int mp = w >> 2, tb = w & 3;
    const int i16 = lane & 15, q4 = i16 >> 2, p4 = i16 & 3, g1 = (lane >> 4) & 1;
    LAS char* Kimg = lds; LAS char* Vimg = lds + 17408;
    LAS float* X = (LAS float*)(lds + 34816);
    const int srow = tid >> 3, piece = tid & 7;
    const int nunits = 1024 + (need_ctx ? 128 : 0);
    for (int u = blockIdx.x; u < nunits; u += gridDim.x) {
        int b, hh, qrow0, n_lat;
        if (u < 1024) { b = u >> 7; hh = (u >> 4) & 7; qrow0 = b * SEQ + (u & 15) * 128; n_lat = 32; }
        else { const int v = u - 1024; b = v >> 4; hh = (v >> 1) & 7; qrow0 = MLAT + b * CTX + (v & 1) * 128; n_lat = 0; }
        const int n = n_lat + 4;
        const int qrow = qrow0 + 32 * tb + r;
        bf16x8 qf[4];
#pragma unroll
        for (int s = 0; s < 4; ++s) qf[s] = *(const bf16x8*)(QKV + (size_t)qrow * NIN_C + (hh * 2 + mp) * 64 + 16 * s + 8 * h);
        float m = -INFINITY, l = 0.f;
        f32x16 O[4];
#pragma unroll
        for (int bk = 0; bk < 4; ++bk)
#pragma unroll
            for (int i = 0; i < 16; ++i) O[bk][i] = 0.f;
        u32x4 kreg[2], vreg[2];
        { const int base = (0 < n_lat) ? b * SEQ : MLAT + b * CTX;
          const bf16_t* gp = QKV + (size_t)(base + srow) * NIN_C + hh * 128 + piece * 8;
          kreg[0] = *(const u32x4*)(gp + 1024); kreg[1] = *(const u32x4*)(gp + 1024 + 64); vreg[0] = *(const u32x4*)(gp + 2048); vreg[1] = *(const u32x4*)(gp + 2048 + 64); }
        for (int i = 0; i < n; ++i) {
            __syncthreads();
            *(LAS u32x4*)(Kimg + srow * 272 + piece * 16) = kreg[0]; *(LAS u32x4*)(Kimg + srow * 272 + 128 + piece * 16) = kreg[1];
            *(LAS u32x4*)(Vimg + srow * 272 + piece * 16) = vreg[0]; *(LAS u32x4*)(Vimg + srow * 272 + 128 + piece * 16) = vreg[1];
            __syncthreads();
            if (i + 1 < n) { const int ii = i + 1; const int base = (ii < n_lat) ? b * SEQ + 64 * ii : MLAT + b * CTX + 64 * (ii - n_lat);
                const bf16_t* gp = QKV + (size_t)(base + srow) * NIN_C + hh * 128 + piece * 8;
                kreg[0] = *(const u32x4*)(gp + 1024); kreg[1] = *(const u32x4*)(gp + 1024 + 64); vreg[0] = *(const u32x4*)(gp + 2048); vreg[1] = *(const u32x4*)(gp + 2048 + 64); }
#pragma unroll
            for (int tile = 0; tile < 2; ++tile) {
                f32x16 S;
#pragma unroll
                for (int e = 0; e < 16; ++e) S[e] = 0.f;
#pragma unroll
                for (int s = 0; s < 4; ++s) { const bf16x8 kf = *(const LAS bf16x8*)(Kimg + (32 * tile + r) * 272 + mp * 128 + (16 * s + 8 * h) * 2); S = MFMA32(kf, qf[s], S); }
                float tmax = S[0];
#pragma unroll
                for (int e = 1; e < 16; ++e) tmax = fmaxf(tmax, S[e]);
                tmax = fmaxf(tmax, __shfl_xor(tmax, 32));
                const float mn = fmaxf(m, tmax), alpha = __expf(m - mn); m = mn;
                float ls = 0.f;
#pragma unroll
                for (int e = 0; e < 16; ++e) { S[e] = __expf(S[e] - mn); ls += S[e]; }
                l = l * alpha + ls;
#pragma unroll
                for (int bk = 0; bk < 4; ++bk)
#pragma unroll
                    for (int e = 0; e < 16; ++e) O[bk][e] *= alpha;
                const bf16x8 pf0 = packP<0>(S), pf1 = packP<1>(S);
#pragma unroll
                for (int blk = 0; blk < 4; ++blk) {
                    const LAS char* vp = Vimg + (32 * tile + 4 * h + q4) * 272 + 2 * (32 * blk + 16 * g1) + 8 * p4;
                    const bf16x8 vf0 = cat8(vtr(vp), vtr(vp + 8 * 272)), vf1 = cat8(vtr(vp + 16 * 272), vtr(vp + 24 * 272));
                    O[blk] = MFMA32(vf0, pf0, O[blk]); O[blk] = MFMA32(vf1, pf1, O[blk]);
                }
            }
        }
        const float inv = 1.f / (l + __shfl_xor(l, 32));
        if (mp == 1) {
#pragma unroll
            for (int blk = 0; blk < 4; ++blk)
#pragma unroll
                for (int e = 0; e < 16; ++e) X[(tb * 128 + 32 * blk + crow(e, h)) * 32 + r] = O[blk][e] * inv;
        }
        __syncthreads();
        if (mp == 0) {
            float ss = 0.f;
#pragma unroll
            for (int blk = 0; blk < 4; ++blk)
#pragma unroll
                for (int e = 0; e < 16; ++e) { const float od = O[blk][e] * inv - lam * X[(tb * 128 + 32 * blk + crow(e, h)) * 32 + r]; O[blk][e] = od; ss += od * od; }
            ss += __shfl_xor(ss, 32);
            const float rstd = one_m_lam_init / sqrtf(ss * (1.f / 128.f) + EPS);
            bf16_t* orow = Obuf + (size_t)qrow * DM + hh * 128 + 4 * h; const float* hn = hnorm + hh * 128 + 4 * h;
#pragma unroll
            for (int blk = 0; blk < 4; ++blk)
#pragma unroll
                for (int ig = 0; ig < 4; ++ig) { const f32x4 gn = *(const f32x4*)(hn + 32 * blk + 8 * ig);
                    u32x2 o; o.x = pk2(O[blk][4 * ig] * rstd * gn[0], O[blk][4 * ig + 1] * rstd * gn[1]); o.y = pk2(O[blk][4 * ig + 2] * rstd * gn[2], O[blk][4 * ig + 3] * rstd * gn[3]);
                    *(u32x2*)(orow + 32 * blk + 8 * ig) = o; }
        }
    }
    __syncthreads();
}
DI void mlstm_scan(LAS char* lds, const bf16_t* QKV, const float* gate_b, bf16_t* HF, bf16_t* HB, bool need_ctx) {
    int tid_ = threadIdx.x; asm volatile("" : "+v"(tid_)); const int tid = tid_, lane = tid & 63, w = __builtin_amdgcn_readfirstlane(tid >> 6), r = lane & 31, h = lane >> 5;
    const int tb = w & 3, dvh = w >> 2, dvb = w & 3, db = w >> 2;
    const int i16 = lane & 15, q4 = i16 >> 2, p4 = i16 & 3, g1 = (lane >> 4) & 1;
    LAS char* Qimg = lds;
    LAS char* Kimg = lds + 18432;
    LAS char* Vimg = lds + 36864;
    LAS char* Cimg = lds + 71680;
    LAS float* bvec = (LAS float*)(lds + 89088);
    LAS float* evec = bvec + 128;
    LAS float* cvec = bvec + 256;
    LAS float* n0 = bvec + 384;
    LAS float* npart = bvec + 448;
    LAS float* scal = bvec + 960;
    for (int it = blockIdx.x; it < 128; it += gridDim.x) {
        const int b = it >> 4, hh = (it >> 1) & 7, dir = it & 1;
        const float gb_i = gate_b[(2 * dir) * 8 + hh], gb_f = gate_b[(2 * dir + 1) * 8 + hh];
        bf16_t* HO = dir ? HB : HF;
        f32x16 Cacc;
#pragma unroll
        for (int e = 0; e < 16; ++e) Cacc[e] = 0.f;
        const int srow = tid >> 2, pc = tid & 3;
        u32x4 qreg[2], kreg[2], vreg[4]; float raw_i = 0.f, raw_f = 0.f;
#define ML_BASE(ci) ((ci) < 2 ? MLAT + b * CTX + 128 * (dir ? 1 - (ci) : (ci)) : b * SEQ + 128 * (dir ? 15 - ((ci) - 2) : ((ci) - 2)))
#define ML_LOAD(ci) do { const int base_ = ML_BASE(ci); const int grow_ = dir ? base_ + 127 - srow : base_ + srow; \
            const bf16_t* gp_ = QKV + (size_t)grow_ * NIN_A + hh * 64 + pc * 8; \
            qreg[0] = *(const u32x4*)(gp_); qreg[1] = *(const u32x4*)(gp_ + 32); kreg[0] = *(const u32x4*)(gp_ + 512); kreg[1] = *(const u32x4*)(gp_ + 512 + 32); \
            const bf16_t* gv_ = QKV + (size_t)grow_ * NIN_A + 1024 + hh * 128 + pc * 8; \
            vreg[0] = *(const u32x4*)(gv_); vreg[1] = *(const u32x4*)(gv_ + 32); vreg[2] = *(const u32x4*)(gv_ + 64); vreg[3] = *(const u32x4*)(gv_ + 96); \
            if (tid < 128) { const int gr2_ = dir ? base_ + 127 - tid : base_ + tid; const bf16_t* gg_ = QKV + (size_t)gr2_ * NIN_A + 3072 + (2 * dir) * 8 + hh; raw_i = bf1(gg_[0]); raw_f = bf1(gg_[8]); } } while (0)
        ML_LOAD(0);
        __syncthreads();
        for (int ci = 0; ci < 18; ++ci) {
            *(LAS u32x4*)(Qimg + srow * 144 + pc * 16) = qreg[0]; *(LAS u32x4*)(Qimg + srow * 144 + 64 + pc * 16) = qreg[1];
            *(LAS u32x4*)(Kimg + srow * 144 + pc * 16) = kreg[0]; *(LAS u32x4*)(Kimg + srow * 144 + 64 + pc * 16) = kreg[1];
#pragma unroll
            for (int k = 0; k < 4; ++k) *(LAS u32x4*)(Vimg + srow * 272 + 64 * k + pc * 16) = vreg[k];
            if (tid < 128) { const float xf = raw_f + gb_f; evec[tid] = raw_i + gb_i; bvec[tid] = fminf(xf, 0.f) - log1pf(__expf(-fabsf(xf))); }
#pragma unroll
            for (int ig = 0; ig < 4; ++ig) { u32x2 o; o.x = pk2(Cacc[4 * ig], Cacc[4 * ig + 1]); o.y = pk2(Cacc[4 * ig + 2], Cacc[4 * ig + 3]);
                *(LAS u32x2*)(Cimg + (32 * db + r) * 272 + 2 * (32 * dvb + 8 * ig + 4 * h)) = o; }
            if (tid < 64) { float nn = 0.f; if (ci > 0) { const float dec = __expf(scal[0] - scal[1]); nn = dec * n0[tid];
#pragma unroll
                    for (int p = 0; p < 8; ++p) nn += npart[p * 64 + tid]; }
                n0[tid] = nn; }
            __syncthreads();
            if (w == 0) {
                const float m0 = (ci > 0) ? scal[2] + scal[1] : 0.f;
                const float lf0 = bvec[2 * lane], lf1 = bvec[2 * lane + 1], li0 = evec[2 * lane], li1 = evec[2 * lane + 1];
                const float s2 = lf0 + lf1; float inc = s2;
#pragma unroll
                for (int o = 1; o < 64; o <<= 1) { const float v = __shfl_up(inc, o); if (lane >= o) inc += v; }
                const float b0 = inc - s2 + lf0, b1 = inc;
                const float e0 = li0 - b0, e1 = li1 - b1;
                float mx = fmaxf(e0, e1);
#pragma unroll
                for (int o = 1; o < 64; o <<= 1) { const float v = __shfl_up(mx, o); if (lane >= o) mx = fmaxf(mx, v); }
                float ex = __shfl_up(mx, 1); if (lane == 0) ex = -INFINITY;
                const float M0 = fmaxf(ex, e0), M1 = mx;
                LDS_WAIT();
                bvec[2 * lane] = b0; bvec[2 * lane + 1] = b1; evec[2 * lane] = e0; evec[2 * lane + 1] = e1;
                cvec[2 * lane] = fmaxf(M0, m0); cvec[2 * lane + 1] = fmaxf(M1, m0);
                if (lane == 63) { scal[0] = m0; scal[1] = fmaxf(M1, m0); scal[2] = b1; }
            }
            __syncthreads();
            if (ci + 1 < 18) ML_LOAD(ci + 1);
            const float m0 = scal[0], c127 = scal[1];
            {
                const int t = 32 * tb + r;
                const float c_t = cvec[t], b_t = bvec[t], cw = __expf(m0 - c_t);
                bf16x8 qf[4];
#pragma unroll
                for (int ks = 0; ks < 4; ++ks) qf[ks] = *(const LAS bf16x8*)(Qimg + t * 144 + (16 * ks + 8 * h) * 2);
                f32x16 acc[2];
#pragma unroll
                for (int e = 0; e < 16; ++e) { acc[0][e] = 0.f; acc[1][e] = 0.f; }
                float dn = 0.f;
#pragma unroll
                for (int ks = 0; ks < 4; ++ks) {
#pragma unroll
                    for (int blk = 0; blk < 2; ++blk) {
                        const LAS char* cp = Cimg + (16 * ks + 8 * h + q4) * 272 + 2 * (64 * dvh + 32 * blk + 16 * g1) + 8 * p4;
                        const bf16x8 cf = cat8(vtr(cp), vtr(cp + 4 * 272));
                        acc[blk] = MFMA32(cf, qf[ks], acc[blk]);
                    }
                    const u32x4 qu = __builtin_bit_cast(u32x4, qf[ks]); const LAS float* np = n0 + 16 * ks + 8 * h;
                    dn += bflo(qu.x) * np[0] + bfhi(qu.x) * np[1] + bflo(qu.y) * np[2] + bfhi(qu.y) * np[3] + bflo(qu.z) * np[4] + bfhi(qu.z) * np[5] + bflo(qu.w) * np[6] + bfhi(qu.w) * np[7];
                }
                dn += __shfl_xor(dn, 32);
#pragma unroll
                for (int e = 0; e < 16; ++e) { acc[0][e] *= cw; acc[1][e] *= cw; }
                float dsum = 0.f;
                for (int st = 0; st <= tb; ++st) {
                    f32x16 S;
#pragma unroll
                    for (int e = 0; e < 16; ++e) S[e] = 0.f;
#pragma unroll
                    for (int ks = 0; ks < 4; ++ks) { const bf16x8 kf = *(const LAS bf16x8*)(Kimg + (32 * st + r) * 144 + (16 * ks + 8 * h) * 2); S = MFMA32(kf, qf[ks], S); }
#pragma unroll
                    for (int e = 0; e < 16; ++e) { const int s = 32 * st + crow(e, h); const float wgt = (s <= t) ? __expf(evec[s] - c_t) : 0.f; S[e] *= wgt; dsum += S[e]; }
                    const bf16x8 pf0 = packP<0>(S), pf1 = packP<1>(S);
#pragma unroll
                    for (int blk = 0; blk < 2; ++blk) {
                        const LAS char* vp = Vimg + (32 * st + 4 * h + q4) * 272 + 2 * (64 * dvh + 32 * blk + 16 * g1) + 8 * p4;
                        const bf16x8 vf0 = cat8(vtr(vp), vtr(vp + 8 * 272)), vf1 = cat8(vtr(vp + 16 * 272), vtr(vp + 24 * 272));
                        acc[blk] = MFMA32(vf0, pf0, acc[blk]); acc[blk] = MFMA32(vf1, pf1, acc[blk]);
                    }
                }
                dsum += __shfl_xor(dsum, 32);
                const float den = dsum + cw * dn;
                const float inv = 1.f / fmaxf(fabsf(den), __expf(-(b_t + c_t)));
                if (ci >= 2 || need_ctx) {
                    const int base = ML_BASE(ci); const int orow_i = dir ? base + 127 - t : base + t;
                    bf16_t* orow = HO + (size_t)orow_i * DM + hh * 128 + 64 * dvh + 4 * h;
#pragma unroll
                    for (int blk = 0; blk < 2; ++blk)
#pragma unroll
                        for (int ig = 0; ig < 4; ++ig) { u32x2 o; o.x = pk2(acc[blk][4 * ig] * inv, acc[blk][4 * ig + 1] * inv); o.y = pk2(acc[blk][4 * ig + 2] * inv, acc[blk][4 * ig + 3] * inv);
                            *(u32x2*)(orow + 32 * blk + 8 * ig) = o; }
                }
            }
            {
                const float dec = __expf(m0 - c127);
#pragma unroll
                for (int e = 0; e < 16; ++e) Cacc[e] *= dec;
#pragma unroll
                for (int ks = 0; ks < 8; ++ks) {
                    const LAS char* vp = Vimg + (16 * ks + 8 * h + q4) * 272 + 2 * (32 * dvb + 16 * g1) + 8 * p4;
                    const bf16x8 vf = cat8(vtr(vp), vtr(vp + 4 * 272));
                    const LAS char* kp = Kimg + (16 * ks + 8 * h + q4) * 144 + 2 * (32 * db + 16 * g1) + 8 * p4;
                    const s16x4 klo = vtr(kp), khi = vtr(kp + 4 * 144);
                    const LAS float* ep = evec + 16 * ks + 8 * h;
                    float kw[8];
#pragma unroll
                    for (int j = 0; j < 4; ++j) { kw[j] = bf1((unsigned short)klo[j]) * __expf(ep[j] - c127); kw[4 + j] = bf1((unsigned short)khi[j]) * __expf(ep[4 + j] - c127); }
                    u32x4 kk; kk.x = pk2(kw[0], kw[1]); kk.y = pk2(kw[2], kw[3]); kk.z = pk2(kw[4], kw[5]); kk.w = pk2(kw[6], kw[7]);
                    Cacc = MFMA32(vf, __builtin_bit_cast(bf16x8, kk), Cacc);
                }
                const int d = tid & 63; float np_ = 0.f;
#pragma unroll
                for (int s = 0; s < 16; ++s) { const int ss = 16 * w + s; np_ += __expf(evec[ss] - c127) * bf1(*(const LAS unsigned short*)(Kimg + ss * 144 + 2 * d)); }
                npart[w * 64 + d] = np_;
            }
            __syncthreads();
        }
#undef ML_LOAD
#undef ML_BASE
    }
    __syncthreads();
}

DI void mlstm_finish_row(const bf16_t* HF, const bf16_t* HB, const bf16_t* QKV, const float* hnorm, bf16_t* Obuf, int row, int lane) {
    const int c0 = 16 * lane;
    const u32x4 f0 = *(const u32x4*)(HF + (size_t)row * DM + c0), f1 = *(const u32x4*)(HF + (size_t)row * DM + c0 + 8);
    const u32x4 b0 = *(const u32x4*)(HB + (size_t)row * DM + c0), b1 = *(const u32x4*)(HB + (size_t)row * DM + c0 + 8);
    const u32x4 o0 = *(const u32x4*)(QKV + (size_t)row * NIN_A + 2048 + c0), o1 = *(const u32x4*)(QKV + (size_t)row * NIN_A + 2048 + c0 + 8);
    float hs[16], og[16];
#pragma unroll
    for (int k = 0; k < 4; ++k) { hs[2 * k] = bflo(f0[k]) + bflo(b0[k]); hs[2 * k + 1] = bfhi(f0[k]) + bfhi(b0[k]); hs[8 + 2 * k] = bflo(f1[k]) + bflo(b1[k]); hs[8 + 2 * k + 1] = bfhi(f1[k]) + bfhi(b1[k]);
        og[2 * k] = bflo(o0[k]); og[2 * k + 1] = bfhi(o0[k]); og[8 + 2 * k] = bflo(o1[k]); og[8 + 2 * k + 1] = bfhi(o1[k]); }
    float ss = 0.f;
#pragma unroll
    for (int k = 0; k < 16; ++k) ss += hs[k] * hs[k];
    ss += __shfl_xor(ss, 1); ss += __shfl_xor(ss, 2); ss += __shfl_xor(ss, 4);
    const float rstd = 1.f / sqrtf(ss * (1.f / 128.f) + EPS);
    float y[16];
#pragma unroll
    for (int k = 0; k < 16; ++k) y[k] = hs[k] * rstd * hnorm[c0 + k] * (1.f / (1.f + __expf(-og[k])));
    u32x4 w0, w1; w0.x = pk2(y[0], y[1]); w0.y = pk2(y[2], y[3]); w0.z = pk2(y[4], y[5]); w0.w = pk2(y[6], y[7]);
    w1.x = pk2(y[8], y[9]); w1.y = pk2(y[10], y[11]); w1.z = pk2(y[12], y[13]); w1.w = pk2(y[14], y[15]);
    *(u32x4*)(Obuf + (size_t)row * DM + c0) = w0; *(u32x4*)(Obuf + (size_t)row * DM + c0 + 8) = w1;
}
DI void p0_phase(const Params& P, LAS char* lds) {
    int tid_ = threadIdx.x; asm volatile("" : "+v"(tid_)); const int tid = tid_;
    float* mods = (float*)(P.ws + WS_MODS); float* rope = (float*)(P.ws + WS_ROPE); float* hc = (float*)(P.ws + WS_HC);
    const float* c = P.in[1]; const float* cctx = P.in[3]; const float* ada_w = P.in[4]; const float* ada_b = P.in[5];
    { const size_t gt = (size_t)blockIdx.x * NTHREADS + tid, gs = (size_t)gridDim.x * NTHREADS;
      const f32x4* xs = (const f32x4*)P.in[0]; f32x4* xd = (f32x4*)P.out;
      for (size_t i = gt; i < (size_t)MLAT * DM / 4; i += gs) xd[i] = xs[i];
      const f32x4* cs = (const f32x4*)P.in[2]; f32x4* cd = (f32x4*)hc;
      for (size_t i = gt; i < (size_t)MCTX * DM / 4; i += gs) cd[i] = cs[i];
      for (size_t i = gt; i < (size_t)SEQ * 32; i += gs) { const int t = (int)(i >> 5), j = (int)(i & 31);
          const float pos = (float)((j < 16) ? (t >> 6) : (t & 63)); const float inv = powf(10000.0f, -(float)(j & 15) / 16.0f); const float ang = pos * inv;
          rope[2 * i] = cosf(ang); rope[2 * i + 1] = sinf(ang); } }
    LAS float* sc = (LAS float*)lds;
    LAS float* part = sc + 9 * 1024;
    for (int i = tid; i < 9 * 1024; i += NTHREADS) { const int idx = i >> 10, k = i & 1023; const float v = idx < 8 ? c[idx * 1024 + k] : cctx[k]; sc[i] = v / (1.f + expf(-v)); }
    __syncthreads();
    for (int item = blockIdx.x; item < 4 * 48; item += gridDim.x) {
        const int l = item / 48, cb = item % 48, col = tid & 127, kq = tid >> 7;
        const float* W = ada_w + (size_t)l * 1024 * 6144 + cb * 128 + col;
        float acc[9];
#pragma unroll
        for (int i = 0; i < 9; ++i) acc[i] = 0.f;
#pragma unroll 8
        for (int k = kq * 256; k < kq * 256 + 256; ++k) { const float wv = W[(size_t)k * 6144];
#pragma unroll
            for (int i = 0; i < 9; ++i) acc[i] += sc[i * 1024 + k] * wv; }
#pragma unroll
        for (int i = 0; i < 9; ++i) part[(kq * 9 + i) * 128 + col] = acc[i];
        __syncthreads();
        for (int o = tid; o < 9 * 128; o += NTHREADS) { const int i = o >> 7, cc = o & 127;
            const float s = (part[(0 * 9 + i) * 128 + cc] + part[(1 * 9 + i) * 128 + cc]) + (part[(2 * 9 + i) * 128 + cc] + part[(3 * 9 + i) * 128 + cc]) + ada_b[l * 6144 + cb * 128 + cc];
            mods[(size_t)(l * 9 + i) * 6144 + cb * 128 + cc] = s; }
        __syncthreads();
    }
}

__global__ void __launch_bounds__(NTHREADS, 2) mega(Params P) {
    extern __shared__ __attribute__((aligned(16))) unsigned char lds_raw[];
    LAS char* lds = (LAS char*)lds_raw;
    cg::grid_group grid = cg::this_grid();
#define THIN_IDS int tid_ = threadIdx.x; asm volatile("" : "+v"(tid_)); const int lane = tid_ & 63, wave = __builtin_amdgcn_readfirstlane(tid_ >> 6); const int gw = blockIdx.x * 8 + wave, NGW = gridDim.x * 8;
    const int lo = P.ph_lo, hi = P.ph_hi;
    int ph = 0;
#define RUN(k) ((k) >= lo && (k) < hi)
#define SEAM(k) do { if ((k) >= lo && (k) + 1 < hi) { if ((k) == 0) { grid.sync(); bar = xcd_barrier_post((unsigned*)(ws + WS_BARW), (volatile LAS unsigned*)(lds + LDS_BYTES - 64)); } else xcd_barrier(bar); } } while (0)
    unsigned char* ws = P.ws;
    float* mods = (float*)(ws + WS_MODS); const float* rope = (const float*)(ws + WS_ROPE); float* hc = (float*)(ws + WS_HC);
    bf16_t* Win = (bf16_t*)(ws + WS_WIN); bf16_t* Wout = (bf16_t*)(ws + WS_WOUT); bf16_t* W1 = (bf16_t*)(ws + WS_W1); bf16_t* W2 = (bf16_t*)(ws + WS_W2);
    bf16_t* Abuf = (bf16_t*)(ws + WS_ABUF); bf16_t* BIG = (bf16_t*)(ws + WS_BIG); bf16_t* HF = (bf16_t*)(ws + WS_HF); bf16_t* HB = (bf16_t*)(ws + WS_HB);
    float* hlat = P.out; float* PART = (float*)(ws + WS_HF);
    XcdBarrier bar; bar.bar = (unsigned*)(ws + WS_BARW); bar.x = 0; bar.st = (volatile LAS unsigned*)(lds + LDS_BYTES - 64);
    if (threadIdx.x < 16) ((volatile LAS unsigned*)(lds + LDS_BYTES - 64))[threadIdx.x] = 0u;
    if (blockIdx.x == 0 && lo == 0) for (int i = threadIdx.x; i < XCD_BAR_WORDS; i += NTHREADS) ((unsigned*)(ws + WS_BARW))[i] = 0u;
    __syncthreads();

    #ifndef REP_P0
#define REP_P0 1
#endif
#ifndef REP_G24
#define REP_G24 1
#endif
#ifndef REP_N1
#define REP_N1 1
#endif
#ifndef REP_N2
#define REP_N2 1
#endif
#ifndef REP_G1
#define REP_G1 1
#endif
#ifndef REP_G3
#define REP_G3 1
#endif
    if (RUN(ph)) for (int rep = 0; rep < REP_P0; ++rep) { p0_phase(P, lds); __syncthreads(); }
    SEAM(ph); ++ph;
#ifdef EXTRA_SYNCS
    if (hi - lo > 1) for (int q = 0; q < EXTRA_SYNCS; ++q) xcd_barrier(bar);
#endif

#pragma unroll 1
    for (int l = 0; l < DEPTH; ++l) {
        const int kind = l % 3, slot = l / 3;
        const bool need_ctx = l < DEPTH - 1;
        const int Mrows = need_ctx ? MTOT : MLAT;
        const int Nin = kind == 0 ? NIN_A : (kind == 1 ? NIN_B : NIN_C);
        const float* modl = mods + (size_t)l * 9 * 6144;
        if (RUN(ph)) for (int rep = 0; rep < REP_N1; ++rep) {
            THIN_IDS
            LAS float* scr = (LAS float*)(lds + wave * 16384);
            ConvDesc cin, cout, c1, c2;
            if (kind == 0) cin = ConvDesc{P.in[10] + (size_t)slot * 1024 * 3104, Win, 1024, 3104, NIN_A, 0, 512, 1024};
            else if (kind == 1) cin = ConvDesc{P.in[14], Win, 1024, 1536, NIN_B, 1280, 0, 1024};
            else cin = ConvDesc{P.in[17], Win, 1024, 3072, NIN_C, 2048, 0, 1024};
            const float* wo = kind == 0 ? P.in[13] + (size_t)slot * 1024 * 1024 : (kind == 1 ? P.in[16] : P.in[23]);
            cout = ConvDesc{wo, Wout, 1024, 1024, 1024, 0, 0, 0};
            c1 = ConvDesc{P.in[8] + (size_t)l * 1024 * 4096, W1, 1024, 4096, 4096, 0, 0, 0};
            c2 = ConvDesc{P.in[9] + (size_t)l * 4096 * 1024, W2, 4096, 1024, 1024, 0, 0, 0};
            const int n_in = 16 * (Nin / 32), n_out = 16 * 32, n_1 = 16 * 128, n_2 = 64 * 32;
            for (int it = gw; it < n_in + n_out + n_1 + n_2; it += NGW) {
                int rr = it;
                if (rr < n_in) { conv_item(cin, scr, rr, lane); continue; } rr -= n_in;
                if (rr < n_out) { conv_item(cout, scr, rr, lane); continue; } rr -= n_out;
                if (rr < n_1) { conv_item(c1, scr, rr, lane); continue; } rr -= n_1;
                conv_item(c2, scr, rr, lane);
            }
            const float* gn = P.in[6] + l * DM;
            for (int row = gw; row < MTOT; row += NGW) {
                const int idx = row < MLAT ? (row >> 11) : 8;
                float* hrow = row < MLAT ? hlat + (size_t)row * DM : hc + (size_t)(row - MLAT) * DM;
                const bool fold = (row >= MLAT) && (l > 0);
                norm_row(hrow, gn, modl + idx * 6144 + 0 * 1024, modl + idx * 6144 + 1 * 1024, Abuf + (size_t)row * DM, lane,
                         fold ? PART + (size_t)(row - MLAT) * DM : nullptr, 8, (size_t)MCTX * DM, modl - 9 * 6144 + 8 * 6144 + 5 * 1024);
            }
        }
        SEAM(ph); ++ph;
        if (RUN(ph)) for (int rep = 0; rep < REP_G1; ++rep) {
            pg8::Gemm g{Abuf, Win, MTOT, Nin, DM, DM}; pg8::StaticOrder S; S.init(MTOT, Nin, gridDim.x, blockIdx.x);
            EpiQKV E{BIG, Nin, kind == 0 ? 0 : (kind == 1 ? 1280 : 2048), rope};
#ifndef DIS_G1
            pg8::gemm_phase<EpiQKV, pg8::StaticOrder, true, true>((LAS unsigned char*)lds, g, S, E);
#endif
        }
        SEAM(ph); ++ph;
        if (RUN(ph)) {
            if (kind == 0) {
#ifndef DIS_ML
                mlstm_scan(lds, BIG, P.in[11] + slot * 32, HF, HB, need_ctx);
#ifdef DBL_ML
                mlstm_scan(lds, BIG, P.in[11] + slot * 32, HF, HB, need_ctx);
#endif
#endif
            } else if (kind == 1) {
#ifndef DIS_SWA
                swa_phase(lds, BIG, Abuf, P.in[15], need_ctx);
#ifdef DBL_SWA
                swa_phase(lds, BIG, Abuf, P.in[15], need_ctx);
#endif
#endif
            }
            else {
                float s1 = 0.f, s2 = 0.f;
                for (int i = 0; i < 64; ++i) { s1 += P.in[18][i] * P.in[19][i]; s2 += P.in[20][i] * P.in[21][i]; }
                const float lam_init = 0.47071301834358416f;
                const float lam = expf(s1) - expf(s2) + lam_init;
#ifndef DIS_DIFF
                diff_phase(lds, BIG, Abuf, P.in[22], lam, 1.f - lam_init, need_ctx);
#ifdef DBL_DIFF
                diff_phase(lds, BIG, Abuf, P.in[22], lam, 1.f - lam_init, need_ctx);
#endif
#endif
            }
        }
        SEAM(ph); ++ph;
        if (kind == 0) {
            if (RUN(ph)) {
                THIN_IDS
                const float* hn = P.in[12] + slot * 1024;
                for (int row = gw; row < Mrows; row += NGW) mlstm_finish_row(HF, HB, BIG, hn, Abuf, row, lane);
            }
            SEAM(ph);
        }
        ++ph;
        if (RUN(ph)) for (int rep = 0; rep < REP_G24; ++rep) {
            pg8::Gemm g{Abuf, Wout, MLAT, DM, DM, DM}; pg8::StaticOrder S; S.init(MLAT, DM, gridDim.x, blockIdx.x);
            EpiResid E{hlat, hc, modl + 2 * 1024, 1.f / REP_G24};
#ifndef DIS_G2
            pg8::gemm_phase<EpiResid, pg8::StaticOrder, true, true>((LAS unsigned char*)lds, g, S, E);
            if (need_ctx) {
                pg8::Gemm g2{Abuf + (size_t)MLAT * DM, Wout, MCTX, DM, DM / 4, DM}; pg8::SplitOrder S2; S2.init(MCTX, DM, 4, gridDim.x, blockIdx.x);
                EpiPartial E2{PART, MCTX};
                pg8::gemm_phase<EpiPartial, pg8::SplitOrder, true, true>((LAS unsigned char*)lds, g2, S2, E2);
            }
#endif
        }
        SEAM(ph); ++ph;
        if (RUN(ph)) for (int rep = 0; rep < REP_N2; ++rep) {
            THIN_IDS
            const float* gn = P.in[7] + l * DM;
            for (int row = gw; row < Mrows; row += NGW) {
                const int idx = row < MLAT ? (row >> 11) : 8;
                float* hrow = row < MLAT ? hlat + (size_t)row * DM : hc + (size_t)(row - MLAT) * DM;
                const bool fold = (row >= MLAT);
                norm_row(hrow, gn, modl + idx * 6144 + 3 * 1024, modl + idx * 6144 + 4 * 1024, Abuf + (size_t)row * DM, lane,
                         fold ? PART + (size_t)(row - MLAT) * DM : nullptr, 4, (size_t)MCTX * DM, modl + 8 * 6144 + 2 * 1024);
            }
        }
        SEAM(ph); ++ph;
        if (RUN(ph)) for (int rep = 0; rep < REP_G3; ++rep) {
            pg8::Gemm g{Abuf, W1, Mrows, DFF, DM, DM}; pg8::StaticOrder S; S.init(Mrows, DFF, gridDim.x, blockIdx.x);
            EpiSqRelu E{BIG, DFF};
#ifndef DIS_G3
            pg8::gemm_phase<EpiSqRelu, pg8::StaticOrder, true, true>((LAS unsigned char*)lds, g, S, E);
#endif
        }
        SEAM(ph); ++ph;
        if (RUN(ph)) for (int rep = 0; rep < REP_G24; ++rep) {
            pg8::Gemm g{BIG, W2, MLAT, DM, DFF, DFF}; pg8::StaticOrder S; S.init(MLAT, DM, gridDim.x, blockIdx.x);
            EpiResid E{hlat, hc, modl + 5 * 1024, 1.f / REP_G24};
#ifndef DIS_G4
            pg8::gemm_phase<EpiResid, pg8::StaticOrder, true, true>((LAS unsigned char*)lds, g, S, E);
            if (need_ctx) {
                pg8::Gemm g2{BIG + (size_t)MLAT * DFF, W2, MCTX, DM, DFF / 8, DFF}; pg8::SplitOrder S2; S2.init(MCTX, DM, 8, gridDim.x, blockIdx.x);
                EpiPartial E2{PART, MCTX};
                pg8::gemm_phase<EpiPartial, pg8::SplitOrder, true, true>((LAS unsigned char*)lds, g2, S2, E2);
            }
#endif
        }
        SEAM(ph); ++ph;
    }
    if (RUN(ph)) {
        THIN_IDS
        for (int row = gw; row < MLAT; row += NGW) {
            float* hrow = hlat + (size_t)row * DM;
            const f32x4* xr = (const f32x4*)hrow + lane;
            f32x4 v[4]; float s = 0.f;
#pragma unroll
            for (int j = 0; j < 4; ++j) { v[j] = xr[64 * j]; s += (v[j][0] * v[j][0] + v[j][1] * v[j][1]) + (v[j][2] * v[j][2] + v[j][3] * v[j][3]); }
            const float rstd = 1.f / sqrtf(wave_sum(s) * (1.f / DM) + EPS);
#pragma unroll
            for (int j = 0; j < 4; ++j) { const f32x4 gg = ((const f32x4*)P.in[24])[lane + 64 * j]; ((f32x4*)hrow)[lane + 64 * j] = v[j] * rstd * gg; }
        }
    }
#undef RUN
#undef SEAM
}
constexpr int N_PHASES = 1 + 8 * DEPTH + 1;

#ifndef MK_MULTI
#define MK_MULTI 0
#endif
extern "C" void kernel_launch(void* const* d_in, const int* in_sizes, int n_in, void* d_out, int out_size, void* d_ws, size_t ws_size, hipStream_t stream) {
    static int grid = 0;
    if (grid == 0) {
        if (n_in != 25 || ws_size < WS_END) { fprintf(stderr, "kernel_launch: unexpected n_in %d / ws_size %zu\n", n_in, ws_size); grid = -1; return; }
        int dev = 0, cus = 0, per_cu = 0;
        hipGetDevice(&dev); hipDeviceGetAttribute(&cus, hipDeviceAttributeMultiprocessorCount, dev);
        if (hipFuncSetAttribute((const void*)mega, hipFuncAttributeMaxDynamicSharedMemorySize, LDS_BYTES) != hipSuccess) { fprintf(stderr, "hipFuncSetAttribute failed\n"); grid = -1; return; }
        if (hipOccupancyMaxActiveBlocksPerMultiprocessor(&per_cu, (const void*)mega, NTHREADS, LDS_BYTES) != hipSuccess || per_cu < 1) { fprintf(stderr, "occupancy query: %d\n", per_cu); per_cu = 1; }
        (void)hipGetLastError();
        grid = cus * (per_cu > 1 ? 1 : per_cu);
    }
    if (grid < 0) return;
    Params p{};
    for (int i = 0; i < 25; ++i) p.in[i] = (const float*)d_in[i];
    p.out = (float*)d_out; p.ws = (unsigned char*)d_ws;
#if MK_MULTI
    for (int k = 0; k < N_PHASES; ++k) { p.ph_lo = k; p.ph_hi = k + 1; hipLaunchKernelGGL(mega, dim3(grid), dim3(NTHREADS), LDS_BYTES, stream, p); }
#else
    p.ph_lo = 0; p.ph_hi = N_PHASES;
    void* args[] = {&p};
    hipError_t e = hipLaunchCooperativeKernel((const void*)mega, dim3(grid), dim3(NTHREADS), args, LDS_BYTES, stream);
    if (e != hipSuccess) fprintf(stderr, "cooperative launch failed: %s (grid %d)\n", hipGetErrorString(e), grid);
#endif
}
```

```cpp
#include <hip/hip_runtime.h>
#include <hip/hip_cooperative_groups.h>
#include <cstdio>
#include <cstdint>
namespace cg = cooperative_groups;
namespace pg8 {
#define PG8_LAS __attribute__((address_space(3)))
typedef unsigned short bf16_t;
typedef short bf16x8 __attribute__((ext_vector_type(8)));
typedef float f32x4 __attribute__((ext_vector_type(4)));
typedef unsigned u32x4 __attribute__((ext_vector_type(4)));
constexpr int BM = 256, BK = 64, HALF = 128, HTB = HALF * BK * 2  , STAGE_BYTES = 8 * HTB, NXCD = 8, WGM = 8;

__host__ __device__ __forceinline__ int lds_byte(int r, int c) { const int st = (r >> 4) * 2 + (c >> 5), rr = r & 15, cc = c & 31, ob = rr * 64 + cc * 2; return st * 1024 + (ob ^ (((ob >> 9) & 1) << 5)); }
__host__ __device__ __forceinline__ void stage_rc(int b, int& R, int& C) { const int st = b / 1024, sb = b % 1024, swz = sb ^ (((sb >> 9) & 1) << 5); R = (st >> 1) * 16 + swz / 64; C = (st & 1) * 32 + (swz % 64) / 2; }
__host__ __device__ __forceinline__ int perm32(int rho) { const int n = rho >> 4, i = rho & 15; return 8 * (i >> 2) + 4 * n + (i & 3); }

struct Unit { int pm, pn, pk; };
struct Gemm { const bf16_t* A; const bf16_t* Bt; int M, N, K, ldk; };

struct StaticOrder {
    int nM, nN, nwg, G, c;
    __host__ __device__ void init(int M, int N, int G_, int c_) { nM = M / BM; nN = N / BM; nwg = nM * nN; G = G_; c = c_; }
    __host__ __device__ bool next(int i, Unit& u) const {
        const long L = (long)i * G + c; if (L >= nwg) return false;
        int wgid = (int)L; { const int q = nwg / NXCD, r = nwg % NXCD, xcd = wgid % NXCD, off = wgid / NXCD; wgid = (xcd < r ? xcd * (q + 1) : r * (q + 1) + (xcd - r) * q) + off; }
        const int nig = WGM * nN, gid = wgid / nig, fm = gid * WGM, gsz = (nM - fm) < WGM ? (nM - fm) : WGM;
        u.pm = fm + ((wgid % nig) % gsz); u.pn = (wgid % nig) / gsz; u.pk = 0; return true;
    }
    __device__ __forceinline__ void a_ready(const Unit&) const {}
    __device__ __forceinline__ void done(const Unit&) const {}
};

struct SplitOrder {
    int nM, nN, nS, nwg, G, c;
    __host__ __device__ void init(int M, int N, int nS_, int G_, int c_) { nM = M / BM; nN = N / BM; nS = nS_; nwg = nM * nN * nS; G = G_; c = c_; }
    __host__ __device__ bool next(int i, Unit& u) const {
        const long L = (long)i * G + c; if (L >= nwg) return false;
        const int w = (int)L; u.pk = w % nS; const int t = w / nS; u.pn = t % nN; u.pm = t / nN; return true;
    }
    __device__ __forceinline__ void a_ready(const Unit&) const {}
    __device__ __forceinline__ void done(const Unit&) const {}
};

__device__ __forceinline__ unsigned cvt_pk_bf16(float lo, float hi) { unsigned r; asm volatile("v_cvt_pk_bf16_f32 %0, %1, %2" : "=v"(r) : "v"(lo), "v"(hi)); return r; }
template <class Epi, class Sched, bool ALIGN_EPI = false, bool SP2 = false>
__device__ __forceinline__ void gemm_phase(PG8_LAS unsigned char* lds, const Gemm g, const Sched& S, const Epi& E) {
    int tid_o = threadIdx.x; asm volatile("" : "+v"(tid_o)); const int tid = tid_o, wid = __builtin_amdgcn_readfirstlane(tid >> 6), lane = tid & 63, wr = wid >> 2, wc = wid & 3, fr = lane & 15, fq = lane >> 4;
    const int K = g.K, nt = K / BK, LDK = g.ldk;
    unsigned voffA[2], voffB[2];
#pragma unroll
    for (int i = 0; i < 2; ++i) { int R, C; stage_rc(tid * 16 + i * 8192, R, C); const int Rb = Epi::PERM ? ((R & ~31) + perm32(R & 31)) : R;
        voffA[i] = (unsigned)(R * LDK + C) * 2u; voffB[i] = (unsigned)(Rb * LDK + C) * 2u; }
    const size_t kstep = (size_t)(BK * 2);
    const size_t hstep = (size_t)HALF * LDK * 2;
    const size_t tstep = 2 * hstep;
    const unsigned ldsw = (unsigned)wid * 1024u;
    const int aoff = lds_byte(wr * 64 + fr, fq * 8), boff = lds_byte(wc * 32 + fr, fq * 8);
#define PG8_SA(b, h) (((b) * 2 + (h)) * HTB)
#define PG8_SB(b, h) ((4 + (b) * 2 + (h)) * HTB)
#define PG8_STAGE(bufoff, gbase, voff) do { _Pragma("unroll") for (int _i = 0; _i < 2; ++_i) \
        __builtin_amdgcn_global_load_lds((const unsigned*)((const char*)(gbase) + (voff)[_i]), (PG8_LAS unsigned*)(lds + (bufoff) + ldsw + _i * 8192), 16, 0, 0); } while (0)
#define PG8_LDA(dst, b, h) do { _Pragma("unroll") for (int m = 0; m < 4; ++m) _Pragma("unroll") for (int k = 0; k < 2; ++k) dst[m][k] = *(const PG8_LAS bf16x8*)(lds + PG8_SA(b, h) + aoff + m * 2048 + k * 1024); } while (0)
#define PG8_LDB(dst, b, h) do { _Pragma("unroll") for (int n = 0; n < 2; ++n) _Pragma("unroll") for (int k = 0; k < 2; ++k) dst[n][k] = *(const PG8_LAS bf16x8*)(lds + PG8_SB(b, h) + boff + n * 2048 + k * 1024); } while (0)
#define PG8_MMA(ai, bj, At, Bt) do { __builtin_amdgcn_s_setprio(1); _Pragma("unroll") for (int m = 0; m < 4; ++m) _Pragma("unroll") for (int n = 0; n < 2; ++n) _Pragma("unroll") for (int k = 0; k < 2; ++k) \
        acc[ai][bj][m][n] = __builtin_amdgcn_mfma_f32_16x16x32_bf16(Bt[n][k], At[m][k], acc[ai][bj][m][n], 0, 0, 0); __builtin_amdgcn_s_setprio(0); } while (0)
#define PG8_WAIT_V(n) asm volatile("s_waitcnt vmcnt(" #n ")" ::: "memory")
#define PG8_WAIT_L(n) asm volatile("s_waitcnt lgkmcnt(" #n ")" ::: "memory")
#define PG8_BAR __builtin_amdgcn_s_barrier()
#define PG8_SCHED __builtin_amdgcn_sched_barrier(0)
    Unit cur, nxt; int ui = 0;
    if (!S.next(0, cur)) return;
    f32x4 acc[2][2][4][2];
#pragma unroll
    for (int a = 0; a < 2; ++a)
#pragma unroll
        for (int b = 0; b < 2; ++b)
#pragma unroll
            for (int m = 0; m < 4; ++m)
#pragma unroll
                for (int n = 0; n < 2; ++n) acc[a][b][m][n] = (f32x4){0.f, 0.f, 0.f, 0.f};
    bf16x8 At[4][2], B0[2][2], B1[2][2];
    const char* cA = (const char*)g.A + (size_t)cur.pm * tstep + (size_t)cur.pk * K * 2; const char* cB = (const char*)g.Bt + (size_t)cur.pn * tstep + (size_t)cur.pk * K * 2;
    S.a_ready(cur);
    if constexpr (SP2) {
        PG8_STAGE(PG8_SB(0, 0), cB, voffB); PG8_STAGE(PG8_SB(0, 1), cB + hstep, voffB); PG8_STAGE(PG8_SA(0, 0), cA, voffA); PG8_STAGE(PG8_SA(0, 1), cA + hstep, voffA);
        if (wr == 1) PG8_BAR;
        PG8_WAIT_V(2); PG8_BAR;
        PG8_STAGE(PG8_SB(1, 0), cB + kstep, voffB); PG8_STAGE(PG8_SA(1, 0), cA + kstep, voffA); PG8_STAGE(PG8_SB(1, 1), cB + hstep + kstep, voffB);
        PG8_WAIT_V(6); PG8_BAR;
    } else {
        PG8_STAGE(PG8_SB(0, 0), cB, voffB); PG8_STAGE(PG8_SA(0, 0), cA, voffA); PG8_STAGE(PG8_SB(0, 1), cB + hstep, voffB); PG8_STAGE(PG8_SA(0, 1), cA + hstep, voffA);
        if (wr == 1) PG8_BAR;
        PG8_WAIT_V(4); PG8_BAR;
        PG8_STAGE(PG8_SB(1, 0), cB + kstep, voffB); PG8_STAGE(PG8_SA(1, 0), cA + kstep, voffA); PG8_STAGE(PG8_SB(1, 1), cB + hstep + kstep, voffB);
        PG8_WAIT_V(6); PG8_BAR;
    }
    for (;;) {
        const bool has_next = S.next(ui + 1, nxt);
        const char* nA = has_next ? (const char*)g.A + (size_t)nxt.pm * tstep + (size_t)nxt.pk * K * 2 : cA; const char* nB = has_next ? (const char*)g.Bt + (size_t)nxt.pn * tstep + (size_t)nxt.pk * K * 2 : cB;
        for (int t = 0; t < nt; t += 2) {
            const bool last = (t == nt - 2);
            const char* a1 = cA + (size_t)(t + 1) * kstep;
            const char* a2 = last ? nA : cA + (size_t)(t + 2) * kstep; const char* b2 = last ? nB : cB + (size_t)(t + 2) * kstep;
            const char* a3 = a2 + kstep; const char* b3 = b2 + kstep;
            if (last && has_next) S.a_ready(nxt);
            if constexpr (SP2) {
            PG8_LDB(B0, 0, 0); PG8_LDB(B1, 0, 1); PG8_SCHED; PG8_LDA(At, 0, 0); PG8_STAGE(PG8_SA(1, 1), a1 + hstep, voffA);
            PG8_WAIT_V(8); PG8_WAIT_L(0); PG8_BAR; PG8_MMA(0, 0, At, B0); PG8_MMA(0, 1, At, B1); PG8_BAR; PG8_SCHED;
            PG8_LDA(At, 0, 1); PG8_STAGE(PG8_SB(0, 0), b2, voffB); PG8_STAGE(PG8_SB(0, 1), b2 + hstep, voffB); PG8_STAGE(PG8_SA(0, 0), a2, voffA);
            PG8_WAIT_V(8); PG8_WAIT_L(0); PG8_BAR; PG8_MMA(1, 0, At, B0); PG8_MMA(1, 1, At, B1); PG8_BAR; PG8_SCHED;
            PG8_LDB(B0, 1, 0); PG8_LDB(B1, 1, 1); PG8_SCHED; PG8_LDA(At, 1, 0); PG8_STAGE(PG8_SA(0, 1), a2 + hstep, voffA);
            PG8_WAIT_V(8); PG8_WAIT_L(0); PG8_BAR; PG8_MMA(0, 0, At, B0); PG8_MMA(0, 1, At, B1); PG8_BAR; PG8_SCHED;
            PG8_LDA(At, 1, 1); PG8_STAGE(PG8_SB(1, 0), b3, voffB); PG8_STAGE(PG8_SB(1, 1), b3 + hstep, voffB); PG8_STAGE(PG8_SA(1, 0), a3, voffA);
            PG8_WAIT_V(8); PG8_WAIT_L(0); PG8_BAR; PG8_MMA(1, 0, At, B0); PG8_MMA(1, 1, At, B1); PG8_BAR; PG8_SCHED;
            } else {
            PG8_LDB(B0, 0, 0); PG8_SCHED; PG8_LDA(At, 0, 0); PG8_STAGE(PG8_SA(1, 1), a1 + hstep, voffA);
            PG8_WAIT_L(8); PG8_BAR; PG8_WAIT_L(0); PG8_MMA(0, 0, At, B0); PG8_BAR; PG8_SCHED;
            PG8_LDB(B1, 0, 1); PG8_STAGE(PG8_SB(0, 0), b2, voffB);
            PG8_BAR; PG8_WAIT_L(0); PG8_MMA(0, 1, At, B1); PG8_BAR;
            PG8_LDA(At, 0, 1); PG8_STAGE(PG8_SA(0, 0), a2, voffA);
            PG8_BAR; PG8_WAIT_L(0); PG8_MMA(1, 0, At, B0); PG8_BAR; PG8_SCHED;
            PG8_STAGE(PG8_SB(0, 1), b2 + hstep, voffB);
            PG8_WAIT_V(6); PG8_BAR; PG8_MMA(1, 1, At, B1); PG8_BAR;
            PG8_LDB(B0, 1, 0); PG8_SCHED; PG8_LDA(At, 1, 0); PG8_STAGE(PG8_SA(0, 1), a2 + hstep, voffA);
            PG8_WAIT_L(8); PG8_BAR; PG8_WAIT_L(0); PG8_MMA(0, 0, At, B0); PG8_BAR; PG8_SCHED;
            PG8_LDB(B1, 1, 1); PG8_STAGE(PG8_SB(1, 0), b3, voffB);
            PG8_BAR; PG8_WAIT_L(0); PG8_MMA(0, 1, At, B1); PG8_BAR;
            PG8_LDA(At, 1, 1); PG8_STAGE(PG8_SA(1, 0), a3, voffA);
            PG8_BAR; PG8_WAIT_L(0); PG8_MMA(1, 0, At, B0); PG8_BAR; PG8_SCHED;
            PG8_STAGE(PG8_SB(1, 1), b3 + hstep, voffB);
            PG8_WAIT_V(6); PG8_BAR; PG8_MMA(1, 1, At, B1); PG8_BAR;
            }
        }
        if constexpr (ALIGN_EPI) { if (wr == 0) PG8_BAR; }
        if constexpr (!Epi::AFTER_DRAIN) { E(acc, cur, wr, wc, fr, fq); S.done(cur); }
        if (!has_next) break;
#pragma unroll
        for (int a = 0; a < 2; ++a)
#pragma unroll
            for (int b = 0; b < 2; ++b)
#pragma unroll
                for (int m = 0; m < 4; ++m)
#pragma unroll
                    for (int n = 0; n < 2; ++n) acc[a][b][m][n] = (f32x4){0.f, 0.f, 0.f, 0.f};
        cur = nxt; cA = nA; cB = nB; ++ui;
        if constexpr (ALIGN_EPI) { if (wr == 1) PG8_BAR; }
    }
    PG8_WAIT_V(0);
    if constexpr (!ALIGN_EPI) { if (wr == 0) PG8_BAR; }
    PG8_BAR;
    if constexpr (Epi::AFTER_DRAIN) { E.fused(acc, cur, wr, wc, fr, fq, lds, wid, lane); S.done(cur); }
#undef PG8_SA
#undef PG8_SB
#undef PG8_STAGE
#undef PG8_LDA
#undef PG8_LDB
#undef PG8_MMA
#undef PG8_WAIT_V
#undef PG8_WAIT_L
#undef PG8_BAR
#undef PG8_SCHED
}
}
using pg8::bf16_t; using pg8::bf16x8; using pg8::f32x4; using pg8::u32x4;
#define LAS __attribute__((address_space(3)))
#define DI __device__ __forceinline__
typedef short s16x4 __attribute__((ext_vector_type(4)));
typedef short v4i16_t __attribute__((ext_vector_type(4)));
typedef float f32x16 __attribute__((ext_vector_type(16)));
typedef float f32x2_t __attribute__((ext_vector_type(2)));
typedef __bf16 bf16x2_t __attribute__((ext_vector_type(2)));
typedef unsigned u32x2 __attribute__((ext_vector_type(2)));
#define MFMA32(a, b, c) __builtin_amdgcn_mfma_f32_32x32x16_bf16((a), (b), (c), 0, 0, 0)

constexpr int DM = 1024, NB = 8, SEQ = 2048, CTX = 256, DEPTH = 4, DFF = 4096;
constexpr int MLAT = NB * SEQ, MCTX = NB * CTX, MTOT = MLAT + MCTX;
constexpr int NIN_A = 3328, NIN_B = 1536, NIN_C = 3072;
constexpr float EPS = 1e-6f;
constexpr size_t MiB = 1u << 20;
constexpr size_t WS_BARW = 1 * MiB + 768 * 1024;
constexpr size_t WS_MODS = 0, WS_ROPE = 1 * MiB, WS_HC = 2 * MiB, WS_WIN = 10 * MiB, WS_WOUT = 17 * MiB, WS_W1 = 19 * MiB, WS_W2 = 27 * MiB,
                 WS_ABUF = 36 * MiB, WS_BIG = 72 * MiB, WS_HF = 216 * MiB, WS_HB = 252 * MiB, WS_END = 288 * MiB;
constexpr int LDS_BYTES = 147456;
constexpr int NTHREADS = 512;

struct Params { const float* in[25]; float* out; unsigned char* ws; int ph_lo, ph_hi; };

DI unsigned pk2(float lo, float hi) { f32x2_t v = {lo, hi}; bf16x2_t b = __builtin_convertvector(v, bf16x2_t); return __builtin_bit_cast(unsigned, b); }
DI float bflo(unsigned u) { return __uint_as_float(u << 16); }
DI float bfhi(unsigned u) { return __uint_as_float(u & 0xffff0000u); }
DI float bf1(unsigned short u) { return __uint_as_float(((unsigned)u) << 16); }
DI float wave_sum(float v) {
#pragma unroll
    for (int o = 1; o < 64; o <<= 1) v += __shfl_xor(v, o);
    return v;
}
DI int crow(int i, int h) { return (i & 3) + 8 * (i >> 2) + 4 * h; }
DI s16x4 vtr(const LAS char* p) { return __builtin_bit_cast(s16x4, __builtin_amdgcn_ds_read_tr16_b64_v4i16((LAS v4i16_t*)p)); }
DI bf16x8 cat8(s16x4 lo, s16x4 hi) { return __builtin_shufflevector(lo, hi, 0, 1, 2, 3, 4, 5, 6, 7); }
template <int S> DI bf16x8 packP(const f32x16& x) {
    u32x4 p; p.x = pk2(x[8 * S + 0], x[8 * S + 1]); p.y = pk2(x[8 * S + 2], x[8 * S + 3]); p.z = pk2(x[8 * S + 4], x[8 * S + 5]); p.w = pk2(x[8 * S + 6], x[8 * S + 7]);
    return __builtin_bit_cast(bf16x8, p);
}
#define LDS_WAIT() asm volatile("s_waitcnt lgkmcnt(0)" ::: "memory")

struct EpiQKV {
    static constexpr bool PERM = true, AFTER_DRAIN = false;
    bf16_t* O; int ldc; int rope_cols; const float* rope;
    DI void operator()(const f32x4 (&acc)[2][2][4][2], const pg8::Unit& u, int wr, int wc, int fr, int fq) const {
        const int row0 = u.pm * 256 + wr * 64 + fr, col0 = u.pn * 256 + wc * 32 + 8 * fq;
        const bool do_rope = (u.pn * 256 < rope_cols) && (u.pm < 64);
#pragma unroll
        for (int ai = 0; ai < 2; ++ai)
#pragma unroll
            for (int m = 0; m < 4; ++m) {
                const int row = row0 + ai * 128 + m * 16; bf16_t* rowp = O + (size_t)row * ldc + col0; const int t = row & 2047;
#pragma unroll
                for (int bj = 0; bj < 2; ++bj) {
                    f32x4 v0 = acc[ai][bj][m][0], v1 = acc[ai][bj][m][1];
                    if (do_rope) {
                        const int j0 = ((col0 + bj * 128) & 63) >> 1;
                        const f32x4 cs0 = *(const f32x4*)(rope + (size_t)(t * 32 + j0) * 2), cs1 = *(const f32x4*)(rope + (size_t)(t * 32 + j0) * 2 + 4);
                        f32x4 r0, r1;
                        r0[0] = v0[0] * cs0[0] - v0[1] * cs0[1]; r0[1] = v0[0] * cs0[1] + v0[1] * cs0[0];
                        r0[2] = v0[2] * cs0[2] - v0[3] * cs0[3]; r0[3] = v0[2] * cs0[3] + v0[3] * cs0[2];
                        r1[0] = v1[0] * cs1[0] - v1[1] * cs1[1]; r1[1] = v1[0] * cs1[1] + v1[1] * cs1[0];
                        r1[2] = v1[2] * cs1[2] - v1[3] * cs1[3]; r1[3] = v1[2] * cs1[3] + v1[3] * cs1[2];
                        v0 = r0; v1 = r1;
                    }
                    u32x4 w; w.x = pk2(v0[0], v0[1]); w.y = pk2(v0[2], v0[3]); w.z = pk2(v1[0], v1[1]); w.w = pk2(v1[2], v1[3]);
                    *(u32x4*)(rowp + bj * 128) = w;
                }
            }
    }
};
struct EpiSqRelu {
    static constexpr bool PERM = true, AFTER_DRAIN = false;
    bf16_t* O; int ldc;
    DI void operator()(const f32x4 (&acc)[2][2][4][2], const pg8::Unit& u, int wr, int wc, int fr, int fq) const {
        const int row0 = u.pm * 256 + wr * 64 + fr, col0 = u.pn * 256 + wc * 32 + 8 * fq;
#pragma unroll
        for (int ai = 0; ai < 2; ++ai)
#pragma unroll
            for (int m = 0; m < 4; ++m) {
                bf16_t* rowp = O + (size_t)(row0 + ai * 128 + m * 16) * ldc + col0;
#pragma unroll
                for (int bj = 0; bj < 2; ++bj) {
                    f32x4 v0 = acc[ai][bj][m][0], v1 = acc[ai][bj][m][1];
#pragma unroll
                    for (int e = 0; e < 4; ++e) { float a = fmaxf(v0[e], 0.f), b = fmaxf(v1[e], 0.f); v0[e] = a * a; v1[e] = b * b; }
                    u32x4 w; w.x = pk2(v0[0], v0[1]); w.y = pk2(v0[2], v0[3]); w.z = pk2(v1[0], v1[1]); w.w = pk2(v1[2], v1[3]);
                    *(u32x4*)(rowp + bj * 128) = w;
                }
            }
    }
};
struct EpiResid {
    static constexpr bool PERM = true, AFTER_DRAIN = false;
    float* hlat; float* hctx; const float* gate_base; float gscale;
    DI void operator()(const f32x4 (&acc)[2][2][4][2], const pg8::Unit& u, int wr, int wc, int fr, int fq) const {
        const int idx = u.pm < 64 ? (u.pm >> 3) : 8;
        float* hb = u.pm < 64 ? hlat + (size_t)u.pm * 256 * DM : hctx + (size_t)(u.pm - 64) * 256 * DM;
        const int col0 = u.pn * 256 + wc * 32 + 8 * fq;
        const float* gp = gate_base + idx * 6144 + col0;
        float* rowp0 = hb + (size_t)(wr * 64 + fr) * DM + col0;
#pragma unroll
        for (int bj = 0; bj < 2; ++bj)
#pragma unroll
            for (int n = 0; n < 2; ++n) {
                const f32x4 g = *(const f32x4*)(gp + bj * 128 + 4 * n) * gscale;
#pragma unroll
                for (int ai = 0; ai < 2; ++ai)
#pragma unroll
                    for (int m = 0; m < 4; ++m) {
                        float* p = rowp0 + (size_t)(ai * 128 + m * 16) * DM + bj * 128 + 4 * n;
                        f32x4 h0 = *(f32x4*)p; h0 = h0 + g * acc[ai][bj][m][n]; *(f32x4*)p = h0;
                    }
            }
    }
};

struct EpiPartial {
    static constexpr bool PERM = true, AFTER_DRAIN = false;
    float* part; int rows;
    DI void operator()(const f32x4 (&acc)[2][2][4][2], const pg8::Unit& u, int wr, int wc, int fr, int fq) const {
        float* base = part + ((size_t)u.pk * rows + u.pm * 256 + wr * 64 + fr) * DM + u.pn * 256 + wc * 32 + 8 * fq;
#pragma unroll
        for (int ai = 0; ai < 2; ++ai)
#pragma unroll
            for (int m = 0; m < 4; ++m)
#pragma unroll
                for (int bj = 0; bj < 2; ++bj) { float* p = base + (size_t)(ai * 128 + m * 16) * DM + bj * 128; *(f32x4*)p = acc[ai][bj][m][0]; *(f32x4*)(p + 4) = acc[ai][bj][m][1]; }
    }
};

DI void norm_row(float* hrow, const float* g, const float* shift, const float* scale, bf16_t* orow, int lane, const float* part, int nsplit, size_t pstride, const float* pgate) {
    const f32x4* xr = (const f32x4*)hrow + lane;
    f32x4 v[4]; float s = 0.f;
#pragma unroll
    for (int j = 0; j < 4; ++j) v[j] = xr[64 * j];
    if (part) {
#pragma unroll
        for (int j = 0; j < 4; ++j) { f32x4 a = ((const f32x4*)part)[lane + 64 * j];
            for (int q = 1; q < nsplit; ++q) a = a + ((const f32x4*)(part + q * pstride))[lane + 64 * j];
            v[j] = v[j] + ((const f32x4*)pgate)[lane + 64 * j] * a; ((f32x4*)hrow)[lane + 64 * j] = v[j]; }
    }
#pragma unroll
    for (int j = 0; j < 4; ++j) s += (v[j][0] * v[j][0] + v[j][1] * v[j][1]) + (v[j][2] * v[j][2] + v[j][3] * v[j][3]);
    const float rstd = 1.f / sqrtf(wave_sum(s) * (1.f / DM) + EPS);
    u32x2* o8 = (u32x2*)orow + lane;
#pragma unroll
    for (int j = 0; j < 4; ++j) {
        const f32x4 gg = ((const f32x4*)g)[lane + 64 * j];
        f32x4 y = v[j] * rstd * gg;
        const f32x4 sh = ((const f32x4*)shift)[lane + 64 * j], sc = ((const f32x4*)scale)[lane + 64 * j]; y = y * (sc + 1.f) + sh;
        u32x2 w; w.x = pk2(y[0], y[1]); w.y = pk2(y[2], y[3]); o8[64 * j] = w;
    }
}
struct ConvDesc { const float* W; bf16_t* WT; int K, Nsrc, Ndst, rope_cols, sc_lo, sc_hi; float sc_val; };
DI void conv_item(const ConvDesc& d, LAS float* scr, int item, int lane) {
    const int nblk = d.Ndst / 32, kb = item / nblk, nb = item % nblk, k0 = 64 * kb, n0 = 32 * nb;
    const int q = lane & 31, nd = n0 + q;
    int ns = nd;
    if (nd < d.rope_cols) { const int head = nd >> 6, p = nd & 63; ns = head * 64 + (p >> 1) + 32 * (p & 1); }
    const bool valid = ns < d.Nsrc;
    const float scl = (nd >= d.sc_lo && nd < d.sc_hi) ? d.sc_val : 1.f;
    const float* src = d.W + (size_t)k0 * d.Nsrc + (valid ? ns : 0);
#pragma unroll 8
    for (int i = 0; i < 32; ++i) { const int kk = 2 * i + (lane >> 5); const float w = src[(size_t)kk * d.Nsrc]; scr[kk * 33 + q] = valid ? w * scl : 0.f; }
    LDS_WAIT();
    const int c = lane & 7;
#pragma unroll
    for (int j = 0; j < 4; ++j) {
        const int n = (lane >> 3) + 8 * j; const LAS float* s = scr + (8 * c) * 33 + n;
        u32x4 o; o.x = pk2(s[0 * 33], s[1 * 33]); o.y = pk2(s[2 * 33], s[3 * 33]); o.z = pk2(s[4 * 33], s[5 * 33]); o.w = pk2(s[6 * 33], s[7 * 33]);
        *(u32x4*)(d.WT + (size_t)(n0 + n) * d.K + k0 + 8 * c) = o;
    }
    LDS_WAIT();
}
#define XB_TMO      128
#define XB_XCNT(j)  (256  + 64 * (j))
#define XB_XSUB(j)  (1280 + 64 * (j))
#define XB_XGEN(j)  (2304 + 64 * (j))
#define XB_TOP      3328
#define XB_TOPGEN   3392
#define XCD_BAR_WORDS 3456
#define XB_SPIN_CAP (1u << 18)

__device__ __forceinline__ unsigned xb_ld(unsigned* p)              { return __hip_atomic_load(p, __ATOMIC_RELAXED, __HIP_MEMORY_SCOPE_AGENT); }
__device__ __forceinline__ unsigned xb_add(unsigned* p, unsigned v) { return __hip_atomic_fetch_add(p, v, __ATOMIC_RELAXED, __HIP_MEMORY_SCOPE_AGENT); }
__device__ __forceinline__ unsigned xb_xcc_id() { return (unsigned)__builtin_amdgcn_s_getreg((3 << 11) | 20) & 0xFu; }
#define XB_SPIN(cond, bar) do { unsigned _sp = 0; while (cond) { __builtin_amdgcn_s_sleep(1); \
    if ((++_sp & 255u) == 0u) { if (xb_ld(&(bar)[XB_TMO])) break; if (_sp > XB_SPIN_CAP) { atomicAdd(&(bar)[XB_TMO], 1u); break; } } } } while (0)

struct XcdBarrier {
    unsigned* bar; unsigned x;
    volatile __attribute__((address_space(3))) unsigned* st;
};

__device__ __forceinline__ XcdBarrier xcd_barrier_post(unsigned* bar, volatile __attribute__((address_space(3))) unsigned* st) {
    XcdBarrier b; b.bar = bar; b.x = xb_xcc_id(); b.st = st;
    if (threadIdx.x == 0) (void)xb_add(&bar[XB_XCNT(b.x)], 1u);
    return b;
}
__device__ __forceinline__ void xcd_barrier_complete(unsigned* bar, unsigned x, unsigned& nloc, unsigned& nx) {
    const unsigned G = gridDim.x * gridDim.y * gridDim.z;
    unsigned sum, cnt, mine, sp = 0u;
    for (;;) {
        sum = 0u; cnt = 0u; mine = 0u;
#pragma unroll
        for (unsigned j = 0; j < 16; ++j) { const unsigned c = xb_ld(&bar[XB_XCNT(j)]); sum += c; cnt += (c > 0u) ? 1u : 0u; mine = (j == x) ? c : mine; }
        if (sum == G) break;
        __builtin_amdgcn_s_sleep(1);
        if ((++sp & 255u) == 0u) { if (xb_ld(&bar[XB_TMO])) break; if (sp > XB_SPIN_CAP) { atomicAdd(&bar[XB_TMO], 1u); break; } }
    }
    nloc = mine > 0u ? mine : 1u; nx = cnt > 0u ? cnt : 1u;
}

__device__ __forceinline__ void xcd_barrier(const XcdBarrier& b) {
    asm volatile("s_waitcnt vmcnt(0)" ::: "memory");
    __syncthreads();
    if (threadIdx.x == 0) {
        unsigned* bar = b.bar;
        __builtin_amdgcn_s_waitcnt(0);
        unsigned nloc = b.st[0], nx = b.st[1];
        if (nloc == 0u) { xcd_barrier_complete(bar, b.x, nloc, nx); b.st[0] = nloc; b.st[1] = nx; }
        const unsigned old = xb_add(&bar[XB_XSUB(b.x)], 1u);
        const unsigned gen = old / nloc;
        if (old + 1u == (gen + 1u) * nloc) {
            __builtin_amdgcn_fence(__ATOMIC_RELEASE, "agent");
            asm volatile("s_waitcnt vmcnt(0)" ::: "memory");
            const unsigned og = xb_add(&bar[XB_TOP], 1u);
            const unsigned tg = og / nx;
            if (og + 1u == (tg + 1u) * nx) xb_add(&bar[XB_TOPGEN], 1u);
            else XB_SPIN(xb_ld(&bar[XB_TOPGEN]) == tg, bar);
            __builtin_amdgcn_fence(__ATOMIC_ACQUIRE, "agent");
            xb_add(&bar[XB_XGEN(b.x)], 1u);
            asm volatile("s_waitcnt vmcnt(0)" ::: "memory");
        } else {
            XB_SPIN(xb_ld(&bar[XB_XGEN(b.x)]) == gen, bar);
            __builtin_amdgcn_fence(__ATOMIC_ACQUIRE, "agent");
            asm volatile("s_waitcnt vmcnt(0)" ::: "memory");
        }
    }
    __syncthreads();
}
DI void swa_phase(LAS char* lds, const bf16_t* QKV, bf16_t* Obuf, const float* sink, bool need_ctx) {
    int tid_ = threadIdx.x; asm volatile("" : "+v"(tid_)); const int tid = tid_, lane = tid & 63, w = __builtin_amdgcn_readfirstlane(tid >> 6), r = lane & 31, h = lane >> 5;
    const int g = w >> 1, th = w & 1;
    const int i16 = lane & 15, q4 = i16 >> 2, p4 = i16 & 3, g1 = (lane >> 4) & 1;
    LAS char* Kimg = lds; LAS char* Vimg = lds + 9216;
    const int srow = tid >> 3, piece = tid & 7;
    const int nunits = 1024 + (need_ctx ? 128 : 0);
    const int vcu = (gridDim.x % 8 == 0) ? (blockIdx.x & 7) * (gridDim.x >> 3) + (blockIdx.x >> 3) : blockIdx.x;
    for (int u = vcu; u < nunits; u += gridDim.x) {
        int b, kvh, qrow0, t0 = 0, c_lo = 0, n_lat = 0;
        if (u < 1024) { b = u >> 7; kvh = (u >> 5) & 3; t0 = (u & 31) * 64; qrow0 = b * SEQ + t0;
            c_lo = t0 == 0 ? 2 : (t0 == 64 ? 1 : 0); int c_hi = (2176 - t0) / 64; if (c_hi > 5) c_hi = 5; n_lat = c_hi - c_lo; }
        else { const int v = u - 1024; b = v >> 4; kvh = (v >> 2) & 3; qrow0 = MLAT + b * CTX + (v & 3) * 64; }
        const int n = n_lat + 4;
        const int qrow = qrow0 + 32 * th + r, hq = kvh * 4 + g;
        bf16x8 qf[4];
#pragma unroll
        for (int s = 0; s < 4; ++s) qf[s] = *(const bf16x8*)(QKV + (size_t)qrow * NIN_B + hq * 64 + 16 * s + 8 * h);
        float m = sink[hq] * 1.4426950408889634f, l = (h == 0) ? 1.f : 0.f;
        f32x16 O[2];
#pragma unroll
        for (int i = 0; i < 16; ++i) { O[0][i] = 0.f; O[1][i] = 0.f; }
        u32x4 kreg, vreg;
        { const int base = (0 < n_lat) ? b * SEQ + t0 - 128 + 64 * c_lo : MLAT + b * CTX;
          const bf16_t* gp = QKV + (size_t)(base + srow) * NIN_B + kvh * 64 + piece * 8; kreg = *(const u32x4*)(gp + 1024); vreg = *(const u32x4*)(gp + 1280); }
        for (int i = 0; i < n; ++i) {
            __syncthreads();
            *(LAS u32x4*)(Kimg + srow * 144 + piece * 16) = kreg; *(LAS u32x4*)(Vimg + srow * 192 + piece * 16) = vreg;
            __syncthreads();
            if (i + 1 < n) { const int ii = i + 1; const int base = (ii < n_lat) ? b * SEQ + t0 - 128 + 64 * (c_lo + ii) : MLAT + b * CTX + 64 * (ii - n_lat);
                const bf16_t* gp = QKV + (size_t)(base + srow) * NIN_B + kvh * 64 + piece * 8; kreg = *(const u32x4*)(gp + 1024); vreg = *(const u32x4*)(gp + 1280); }
            const bool masked = i < n_lat; const int kpos0 = t0 - 128 + 64 * (c_lo + i), qp = t0 + 32 * th + r;
            {
                f32x16 S0, S1;
#pragma unroll
                for (int e = 0; e < 16; ++e) { S0[e] = 0.f; S1[e] = 0.f; }
#pragma unroll
                for (int s = 0; s < 4; ++s) { const LAS char* kp = Kimg + r * 144 + (16 * s + 8 * h) * 2;
                    const bf16x8 kf0 = *(const LAS bf16x8*)kp, kf1 = *(const LAS bf16x8*)(kp + 32 * 144); S0 = MFMA32(kf0, qf[s], S0); S1 = MFMA32(kf1, qf[s], S1); }
                if (masked) {
#pragma unroll
                    for (int e = 0; e < 16; ++e) { const int d = kpos0 + crow(e, h) - qp; if (d > 128 || d < -128) S0[e] = -INFINITY; if (d + 32 > 128 || d + 32 < -128) S1[e] = -INFINITY; }
                }
                float tmax = fmaxf(S0[0], S1[0]);
#pragma unroll
                for (int e = 1; e < 16; ++e) tmax = fmaxf(tmax, fmaxf(S0[e], S1[e]));
                tmax = fmaxf(tmax, __shfl_xor(tmax, 32));
                if (__any(tmax > m + 8.f)) {
                    const float mn = fmaxf(m, tmax), alpha = __builtin_amdgcn_exp2f(m - mn); m = mn; l *= alpha;
#pragma unroll
                    for (int e = 0; e < 16; ++e) { O[0][e] *= alpha; O[1][e] *= alpha; }
                }
                float ls = 0.f;
#pragma unroll
                for (int e = 0; e < 16; ++e) { S0[e] = __builtin_amdgcn_exp2f(S0[e] - m); S1[e] = __builtin_amdgcn_exp2f(S1[e] - m); ls += S0[e] + S1[e]; }
                l += ls;
                const bf16x8 pa0 = packP<0>(S0), pa1 = packP<1>(S0), pb0 = packP<0>(S1), pb1 = packP<1>(S1);
#pragma unroll
                for (int blk = 0; blk < 2; ++blk) {
                    const LAS char* vp = Vimg + (4 * h + q4) * 192 + 2 * (32 * blk + 16 * g1) + 8 * p4;
                    const bf16x8 vf0 = cat8(vtr(vp), vtr(vp + 8 * 192)), vf1 = cat8(vtr(vp + 16 * 192), vtr(vp + 24 * 192));
                    const bf16x8 vf2 = cat8(vtr(vp + 32 * 192), vtr(vp + 40 * 192)), vf3 = cat8(vtr(vp + 48 * 192), vtr(vp + 56 * 192));
                    O[blk] = MFMA32(vf0, pa0, O[blk]); O[blk] = MFMA32(vf1, pa1, O[blk]); O[blk] = MFMA32(vf2, pb0, O[blk]); O[blk] = MFMA32(vf3, pb1, O[blk]);
                }
            }
        }
        const float inv = 1.f / (l + __shfl_xor(l, 32));
        bf16_t* orow = Obuf + (size_t)qrow * DM + hq * 64 + 4 * h;
#pragma unroll
        for (int blk = 0; blk < 2; ++blk)
#pragma unroll
            for (int ig = 0; ig < 4; ++ig) { u32x2 o; o.x = pk2(O[blk][4 * ig] * inv, O[blk][4 * ig + 1] * inv); o.y = pk2(O[blk][4 * ig + 2] * inv, O[blk][4 * ig + 3] * inv);
                *(u32x2*)(orow + 32 * blk + 8 * ig) = o; }
    }
    __syncthreads();
}

DI void diff_phase(LAS char* lds, const bf16_t* QKV, bf16_t* Obuf, const float* hnorm, float lam, float one_m_lam_init, bool need_ctx) {
    int tid_ = threadIdx.x; asm volatile("" : "+v"(tid_)); const int tid = tid_, lane = tid & 63, w = __builtin_amdgcn_readfirstlane(tid >> 6), r = lane & 31, h = lane >> 5;
    const int mp = w >> 2, tb = w & 3;
    const int i16 = lane & 15, q4 = i16 >> 2, p4 = i16 & 3, g1 = (lane >> 4) & 1;
    constexpr int IMG = 17408, VIMG = 20480;
    LAS char* Kb = lds; LAS char* Vb = lds + 2 * IMG;
    LAS float* X = (LAS float*)(lds + 2 * IMG + 2 * VIMG);
    const int srow = tid >> 3, piece = tid & 7;
    const int wofs = srow * 272 + piece * 16, wofsv = srow * 320 + piece * 16;
    const int nunits = 1024 + (need_ctx ? 128 : 0);
    const int vcu = (gridDim.x % 8 == 0) ? (blockIdx.x & 7) * (gridDim.x >> 3) + (blockIdx.x >> 3) : blockIdx.x;
    for (int u = vcu; u < nunits; u += gridDim.x) {
        int b, hh, qrow0, n_lat;
        if (u < 1024) { b = u >> 7; hh = (u >> 4) & 7; qrow0 = b * SEQ + (u & 15) * 128; n_lat = 32; }
        else { const int v = u - 1024; b = v >> 4; hh = (v >> 1) & 7; qrow0 = MLAT + b * CTX + (v & 1) * 128; n_lat = 0; }
        const int n = n_lat + 4;
        const int qrow = qrow0 + 32 * tb + r;
        const bf16_t* gbase = QKV + (size_t)srow * NIN_C + hh * 128 + piece * 8;
#define DF_ROWS(ii) ((ii) < n_lat ? b * SEQ + 64 * (ii) : MLAT + b * CTX + 64 * ((ii) - n_lat))
#define DF_LOADK(ii) do { const bf16_t* gp_ = gbase + (size_t)DF_ROWS(ii) * NIN_C; kreg[0] = *(const u32x4*)(gp_ + 1024); kreg[1] = *(const u32x4*)(gp_ + 1024 + 64); } while (0)
#define DF_LOADV(ii) do { const bf16_t* gp_ = gbase + (size_t)DF_ROWS(ii) * NIN_C; vreg[0] = *(const u32x4*)(gp_ + 2048); vreg[1] = *(const u32x4*)(gp_ + 2048 + 64); } while (0)
#define DF_WRITEK(buf) do { *(LAS u32x4*)(Kb + (buf) * IMG + wofs) = kreg[0]; *(LAS u32x4*)(Kb + (buf) * IMG + wofs + 128) = kreg[1]; } while (0)
#define DF_WRITEV(buf) do { *(LAS u32x4*)(Vb + (buf) * VIMG + wofsv) = vreg[0]; *(LAS u32x4*)(Vb + (buf) * VIMG + wofsv + 128) = vreg[1]; } while (0)
#define DF_QK(Sa, Sb, buf) do { _Pragma("unroll") for (int e = 0; e < 16; ++e) { Sa[e] = 0.f; Sb[e] = 0.f; } \
            _Pragma("unroll") for (int s = 0; s < 4; ++s) { const LAS char* kp = Kb + (buf) * IMG + r * 272 + mp * 128 + (16 * s + 8 * h) * 2; \
                const bf16x8 kf0 = *(const LAS bf16x8*)kp, kf1 = *(const LAS bf16x8*)(kp + 32 * 272); Sa = MFMA32(kf0, qf[s], Sa); Sb = MFMA32(kf1, qf[s], Sb); } } while (0)
        bf16x8 qf[4];
#pragma unroll
        for (int s = 0; s < 4; ++s) qf[s] = *(const bf16x8*)(QKV + (size_t)qrow * NIN_C + (hh * 2 + mp) * 64 + 16 * s + 8 * h);
        float m = -INFINITY, l = 0.f;
        f32x16 O[4];
#pragma unroll
        for (int bk = 0; bk < 4; ++bk)
#pragma unroll
            for (int i = 0; i < 16; ++i) O[bk][i] = 0.f;
        u32x4 kreg[2], vreg[2];
        f32x16 S0, S1, T0, T1;
        __syncthreads();
        DF_LOADK(0); DF_LOADV(0); DF_WRITEK(0); DF_WRITEV(0);
        DF_LOADK(1); DF_WRITEK(1);
        DF_LOADK(2); DF_LOADV(1);
        __syncthreads();
        DF_QK(S0, S1, 0);
        __syncthreads();
        if (w >= 4) __syncthreads();
        for (int i = 0; i < n; ++i) {
            const int cur = i & 1;
            if (i + 2 < n) DF_WRITEK(cur);
            if (i + 3 < n) DF_LOADK(i + 3);
            if (i + 1 < n) DF_QK(T0, T1, cur ^ 1);
            float tmax = fmaxf(S0[0], S1[0]);
#pragma unroll
            for (int e = 1; e < 16; ++e) tmax = fmaxf(tmax, fmaxf(S0[e], S1[e]));
            tmax = fmaxf(tmax, __shfl_xor(tmax, 32));
            if (__any(tmax > m + 8.f)) {
                const float mn = fmaxf(m, tmax), alpha = __builtin_amdgcn_exp2f(m - mn); m = mn; l *= alpha;
#pragma unroll
                for (int bk = 0; bk < 4; ++bk)
#pragma unroll
                    for (int e = 0; e < 16; ++e) O[bk][e] *= alpha;
            }
            float ls = 0.f;
#pragma unroll
            for (int e = 0; e < 16; ++e) { S0[e] = __builtin_amdgcn_exp2f(S0[e] - m); S1[e] = __builtin_amdgcn_exp2f(S1[e] - m); ls += S0[e] + S1[e]; }
            l += ls;
            const bf16x8 pa0 = packP<0>(S0), pa1 = packP<1>(S0), pb0 = packP<0>(S1), pb1 = packP<1>(S1);
            __syncthreads();
            if (i + 1 < n) DF_WRITEV(cur ^ 1);
            if (i + 2 < n) DF_LOADV(i + 2);
#pragma unroll
            for (int blk = 0; blk < 4; ++blk) {
                const LAS char* vp = Vb + cur * VIMG + (4 * h + q4) * 320 + 2 * (32 * blk + 16 * g1) + 8 * p4;
                const bf16x8 vf0 = cat8(vtr(vp), vtr(vp + 8 * 320)), vf1 = cat8(vtr(vp + 16 * 320), vtr(vp + 24 * 320));
                const bf16x8 vf2 = cat8(vtr(vp + 32 * 320), vtr(vp + 40 * 320)), vf3 = cat8(vtr(vp + 48 * 320), vtr(vp + 56 * 320));
                O[blk] = MFMA32(vf0, pa0, O[blk]); O[blk] = MFMA32(vf1, pa1, O[blk]); O[blk] = MFMA32(vf2, pb0, O[blk]); O[blk] = MFMA32(vf3, pb1, O[blk]);
            }
            S0 = T0; S1 = T1;
            __syncthreads();
        }
        if (w < 4) __syncthreads();
#undef DF_ROWS
#undef DF_LOADK
#undef DF_LOADV
#undef DF_WRITEK
#undef DF_WRITEV
#undef DF_QK
        const float inv = 1.f / (l + __shfl_xor(l, 32));
        if (mp == 1) {
#pragma unroll
            for (int blk = 0; blk < 4; ++blk)
#pragma unroll
                for (int e = 0; e < 16; ++e) X[(tb * 128 + 32 * blk + crow(e, h)) * 32 + r] = O[blk][e] * inv;
        }
        __syncthreads();
        if (mp == 0) {
            float ss = 0.f;
#pragma unroll
            for (int blk = 0; blk < 4; ++blk)
#pragma unroll
                for (int e = 0; e < 16; ++e) { const float od = O[blk][e] * inv - lam * X[(tb * 128 + 32 * blk + crow(e, h)) * 32 + r]; O[blk][e] = od; ss += od * od; }
            ss += __shfl_xor(ss, 32);
            const float rstd = one_m_lam_init / sqrtf(ss * (1.f / 128.f) + EPS);
            bf16_t* orow = Obuf + (size_t)qrow * DM + hh * 128 + 4 * h; const float* hn = hnorm + hh * 128 + 4 * h;
#pragma unroll
            for (int blk = 0; blk < 4; ++blk)
#pragma unroll
                for (int ig = 0; ig < 4; ++ig) { const f32x4 gn = *(const f32x4*)(hn + 32 * blk + 8 * ig);
                    u32x2 o; o.x = pk2(O[blk][4 * ig] * rstd * gn[0], O[blk][4 * ig + 1] * rstd * gn[1]); o.y = pk2(O[blk][4 * ig + 2] * rstd * gn[2], O[blk][4 * ig + 3] * rstd * gn[3]);
                    *(u32x2*)(orow + 32 * blk + 8 * ig) = o; }
        }
    }
    __syncthreads();
}
DI void mlstm_scan(LAS char* lds, const bf16_t* QKV, const float* gate_b, bf16_t* HF, bf16_t* HB, bool need_ctx) {
    int tid_ = threadIdx.x; asm volatile("" : "+v"(tid_)); const int tid = tid_, lane = tid & 63, w = __builtin_amdgcn_readfirstlane(tid >> 6), r = lane & 31, h = lane >> 5;
    const int dvq = w >> 2, tb = (w < 4) ? w : 7 - w;
    const bool st_wave = tb <= 1; const int dvb = dvq, db = tb;
    const int i16 = lane & 15, q4 = i16 >> 2, p4 = i16 & 3, g1 = (lane >> 4) & 1;
    LAS char* Qimg = lds;
    LAS char* Kimg = lds + 18432;
    LAS char* Vimg = lds + 36864;
    LAS char* Cimg = lds + 61440;
    LAS float* bv = (LAS float*)(lds + 73728);
    LAS float* ev = bv + 18 * 128;
    LAS float* Mv = ev + 18 * 128;
    LAS float* n0 = Mv + 18 * 128;
    LAS float* npart = n0 + 64;
    LAS float* M127 = npart + 512;
    LAS float* blast = M127 + 32;
    for (int it = blockIdx.x; it < 256; it += gridDim.x) {
        const int b = it >> 5, hh = (it >> 2) & 7, dir = (it >> 1) & 1, dvh = it & 1;
        const float gb_i = gate_b[(2 * dir) * 8 + hh], gb_f = gate_b[(2 * dir + 1) * 8 + hh];
        bf16_t* HO = dir ? HB : HF;
        f32x16 Cacc;
#pragma unroll
        for (int e = 0; e < 16; ++e) Cacc[e] = 0.f;
        const int srow = tid >> 2, pc = tid & 3;
        u32x4 qreg[2], kreg[2], vreg[2];
#define ML_BASE(ci) ((ci) < 2 ? MLAT + b * CTX + 128 * (dir ? 1 - (ci) : (ci)) : b * SEQ + 128 * (dir ? 15 - ((ci) - 2) : ((ci) - 2)))
#define ML_LOAD(ci) do { const int base_ = ML_BASE(ci); const int grow_ = dir ? base_ + 127 - srow : base_ + srow; \
            const bf16_t* gp_ = QKV + (size_t)grow_ * NIN_A + hh * 64 + pc * 8; \
            qreg[0] = *(const u32x4*)(gp_); qreg[1] = *(const u32x4*)(gp_ + 32); kreg[0] = *(const u32x4*)(gp_ + 512); kreg[1] = *(const u32x4*)(gp_ + 512 + 32); \
            const bf16_t* gv_ = QKV + (size_t)grow_ * NIN_A + 1024 + hh * 128 + dvh * 64 + pc * 8; \
            vreg[0] = *(const u32x4*)(gv_); vreg[1] = *(const u32x4*)(gv_ + 32); } while (0)
        ML_LOAD(0);
        __syncthreads();
        for (int idx = tid; idx < 18 * 128; idx += NTHREADS) {
            const int ci = idx >> 7, tp = idx & 127; const int base = ML_BASE(ci); const int grow = dir ? base + 127 - tp : base + tp;
            const bf16_t* gg = QKV + (size_t)grow * NIN_A + 3072 + (2 * dir) * 8 + hh;
            const float xi = bf1(gg[0]) + gb_i, xf = bf1(gg[8]) + gb_f;
            ev[idx] = xi; bv[idx] = fminf(xf, 0.f) - __logf(1.f + __expf(-fabsf(xf)));
        }
        __syncthreads();
        for (int ci = w; ci < 18; ci += 8) {
            LAS float* bc = bv + ci * 128; LAS float* ec = ev + ci * 128; LAS float* mc = Mv + ci * 128;
            const float lf0 = bc[2 * lane], lf1 = bc[2 * lane + 1], li0 = ec[2 * lane], li1 = ec[2 * lane + 1];
            const float s2 = lf0 + lf1; float inc = s2;
#pragma unroll
            for (int o = 1; o < 64; o <<= 1) { const float v = __shfl_up(inc, o); if (lane >= o) inc += v; }
            const float b0 = inc - s2 + lf0, b1 = inc;
            const float e0 = li0 - b0, e1 = li1 - b1;
            float mx = fmaxf(e0, e1);
#pragma unroll
            for (int o = 1; o < 64; o <<= 1) { const float v = __shfl_up(mx, o); if (lane >= o) mx = fmaxf(mx, v); }
            float ex = __shfl_up(mx, 1); if (lane == 0) ex = -INFINITY;
            bc[2 * lane] = b0; bc[2 * lane + 1] = b1; ec[2 * lane] = e0; ec[2 * lane + 1] = e1;
            mc[2 * lane] = fmaxf(ex, e0); mc[2 * lane + 1] = mx;
            if (lane == 63) { M127[ci] = mx; blast[ci] = b1; }
        }
        if (tid < 64) n0[tid] = 0.f;
        __syncthreads();
        float m0 = 0.f, dec_prev = 0.f;
        for (int ci = 0; ci < 18; ++ci) {
            const float c127 = fmaxf(M127[ci], m0), dec = __expf(m0 - c127);
            {
                const float us = __expf(ev[ci * 128 + srow] - c127);
                *(LAS u32x4*)(Qimg + srow * 144 + pc * 16) = qreg[0]; *(LAS u32x4*)(Qimg + srow * 144 + 64 + pc * 16) = qreg[1];
#pragma unroll
                for (int k = 0; k < 2; ++k) { u32x4 o;
#pragma unroll
                    for (int e = 0; e < 4; ++e) o[e] = pk2(bflo(kreg[k][e]) * us, bfhi(kreg[k][e]) * us);
                    *(LAS u32x4*)(Kimg + srow * 144 + 64 * k + pc * 16) = o; }
                *(LAS u32x4*)(Vimg + srow * 192 + pc * 16) = vreg[0]; *(LAS u32x4*)(Vimg + srow * 192 + 64 + pc * 16) = vreg[1];
                if (st_wave) {
#pragma unroll
                    for (int ig = 0; ig < 4; ++ig) { u32x2 o; o.x = pk2(Cacc[4 * ig], Cacc[4 * ig + 1]); o.y = pk2(Cacc[4 * ig + 2], Cacc[4 * ig + 3]);
                        *(LAS u32x2*)(Cimg + (32 * db + r) * 192 + 2 * (32 * dvb + 8 * ig + 4 * h)) = o; }
                }
                if (tid < 64 && ci > 0) { float nn = dec_prev * n0[tid];
#pragma unroll
                    for (int p = 0; p < 8; ++p) nn += npart[p * 64 + tid];
                    n0[tid] = nn; }
            }
            __syncthreads();
            if (ci + 1 < 18) ML_LOAD(ci + 1);
            {
                const int t = 32 * tb + r;
                const float c_t = fmaxf(Mv[ci * 128 + t], m0), b_t = bv[ci * 128 + t], r_t = __expf(c127 - c_t);
                bf16x8 qf[4];
#pragma unroll
                for (int ks = 0; ks < 4; ++ks) qf[ks] = *(const LAS bf16x8*)(Qimg + t * 144 + (16 * ks + 8 * h) * 2);
                f32x16 acc;
#pragma unroll
                for (int e = 0; e < 16; ++e) acc[e] = 0.f;
                float dn = 0.f;
#pragma unroll
                for (int ks = 0; ks < 4; ++ks) {
                    const LAS char* cp = Cimg + (16 * ks + 8 * h + q4) * 192 + 2 * (32 * dvq + 16 * g1) + 8 * p4;
                    const bf16x8 cf = cat8(vtr(cp), vtr(cp + 4 * 192));
                    acc = MFMA32(cf, qf[ks], acc);
                    const u32x4 qu = __builtin_bit_cast(u32x4, qf[ks]); const LAS float* np = n0 + 16 * ks + 8 * h;
                    dn += bflo(qu.x) * np[0] + bfhi(qu.x) * np[1] + bflo(qu.y) * np[2] + bfhi(qu.y) * np[3] + bflo(qu.z) * np[4] + bfhi(qu.z) * np[5] + bflo(qu.w) * np[6] + bfhi(qu.w) * np[7];
                }
                dn += __shfl_xor(dn, 32);
#pragma unroll
                for (int e = 0; e < 16; ++e) acc[e] *= dec;
                float dsum = 0.f;
                for (int st = 0; st <= tb; ++st) {
                    f32x16 S;
#pragma unroll
                    for (int e = 0; e < 16; ++e) S[e] = 0.f;
#pragma unroll
                    for (int ks = 0; ks < 4; ++ks) { const bf16x8 kf = *(const LAS bf16x8*)(Kimg + (32 * st + r) * 144 + (16 * ks + 8 * h) * 2); S = MFMA32(kf, qf[ks], S); }
                    if (st == tb) {
#pragma unroll
                        for (int e = 0; e < 16; ++e) if (crow(e, h) > r) S[e] = 0.f;
                    }
#pragma unroll
                    for (int e = 0; e < 16; ++e) dsum += S[e];
                    const bf16x8 pf0 = packP<0>(S), pf1 = packP<1>(S);
                    const LAS char* vp = Vimg + (32 * st + 4 * h + q4) * 192 + 2 * (32 * dvq + 16 * g1) + 8 * p4;
                    const bf16x8 vf0 = cat8(vtr(vp), vtr(vp + 8 * 192)), vf1 = cat8(vtr(vp + 16 * 192), vtr(vp + 24 * 192));
                    acc = MFMA32(vf0, pf0, acc); acc = MFMA32(vf1, pf1, acc);
                }
                dsum += __shfl_xor(dsum, 32);
                const float den = r_t * (dsum + dec * dn);
                const float inv = r_t / fmaxf(fabsf(den), __expf(-(b_t + c_t)));
                if (ci >= 2 || need_ctx) {
                    const int base = ML_BASE(ci); const int orow_i = dir ? base + 127 - t : base + t;
                    bf16_t* orow = HO + (size_t)orow_i * DM + hh * 128 + dvh * 64 + 32 * dvq + 4 * h;
#pragma unroll
                    for (int ig = 0; ig < 4; ++ig) { u32x2 o; o.x = pk2(acc[4 * ig] * inv, acc[4 * ig + 1] * inv); o.y = pk2(acc[4 * ig + 2] * inv, acc[4 * ig + 3] * inv);
                        *(u32x2*)(orow + 8 * ig) = o; }
                }
            }
            if (st_wave) {
#pragma unroll
                for (int e = 0; e < 16; ++e) Cacc[e] *= dec;
#pragma unroll
                for (int ks = 0; ks < 8; ++ks) {
                    const LAS char* vp = Vimg + (16 * ks + 8 * h + q4) * 192 + 2 * (32 * dvb + 16 * g1) + 8 * p4;
                    const bf16x8 vf = cat8(vtr(vp), vtr(vp + 4 * 192));
                    const LAS char* kp = Kimg + (16 * ks + 8 * h + q4) * 144 + 2 * (32 * db + 16 * g1) + 8 * p4;
                    const bf16x8 kf = cat8(vtr(kp), vtr(kp + 4 * 144));
                    Cacc = MFMA32(vf, kf, Cacc);
                }
            }
            {
                const int d = tid & 63; float np_ = 0.f;
#pragma unroll
                for (int s = 0; s < 16; ++s) np_ += bf1(*(const LAS unsigned short*)(Kimg + (16 * w + s) * 144 + 2 * d));
                npart[w * 64 + d] = np_;
            }
            dec_prev = dec; m0 = blast[ci] + c127;
            __syncthreads();
        }
#undef ML_LOAD
#undef ML_BASE
    }
    __syncthreads();
}

DI void mlstm_finish_row(const bf16_t* HF, const bf16_t* HB, const bf16_t* QKV, const float* hnorm, bf16_t* Obuf, int row, int lane) {
    const int c0 = 16 * lane;
    const u32x4 f0 = *(const u32x4*)(HF + (size_t)row * DM + c0), f1 = *(const u32x4*)(HF + (size_t)row * DM + c0 + 8);
    const u32x4 b0 = *(const u32x4*)(HB + (size_t)row * DM + c0), b1 = *(const u32x4*)(HB + (size_t)row * DM + c0 + 8);
    const u32x4 o0 = *(const u32x4*)(QKV + (size_t)row * NIN_A + 2048 + c0), o1 = *(const u32x4*)(QKV + (size_t)row * NIN_A + 2048 + c0 + 8);
    float hs[16], og[16];
#pragma unroll
    for (int k = 0; k < 4; ++k) { hs[2 * k] = bflo(f0[k]) + bflo(b0[k]); hs[2 * k + 1] = bfhi(f0[k]) + bfhi(b0[k]); hs[8 + 2 * k] = bflo(f1[k]) + bflo(b1[k]); hs[8 + 2 * k + 1] = bfhi(f1[k]) + bfhi(b1[k]);
        og[2 * k] = bflo(o0[k]); og[2 * k + 1] = bfhi(o0[k]); og[8 + 2 * k] = bflo(o1[k]); og[8 + 2 * k + 1] = bfhi(o1[k]); }
    float ss = 0.f;
#pragma unroll
    for (int k = 0; k < 16; ++k) ss += hs[k] * hs[k];
    ss += __shfl_xor(ss, 1); ss += __shfl_xor(ss, 2); ss += __shfl_xor(ss, 4);
    const float rstd = 1.f / sqrtf(ss * (1.f / 128.f) + EPS);
    float y[16];
#pragma unroll
    for (int k = 0; k < 16; ++k) y[k] = hs[k] * rstd * hnorm[c0 + k] * (1.f / (1.f + __expf(-og[k])));
    u32x4 w0, w1; w0.x = pk2(y[0], y[1]); w0.y = pk2(y[2], y[3]); w0.z = pk2(y[4], y[5]); w0.w = pk2(y[6], y[7]);
    w1.x = pk2(y[8], y[9]); w1.y = pk2(y[10], y[11]); w1.z = pk2(y[12], y[13]); w1.w = pk2(y[14], y[15]);
    *(u32x4*)(Obuf + (size_t)row * DM + c0) = w0; *(u32x4*)(Obuf + (size_t)row * DM + c0 + 8) = w1;
}
DI void p0_phase(const Params& P, LAS char* lds) {
    int tid_ = threadIdx.x; asm volatile("" : "+v"(tid_)); const int tid = tid_;
    float* mods = (float*)(P.ws + WS_MODS); float* rope = (float*)(P.ws + WS_ROPE); float* hc = (float*)(P.ws + WS_HC);
    const float* c = P.in[1]; const float* cctx = P.in[3]; const float* ada_w = P.in[4]; const float* ada_b = P.in[5];
    { const size_t gt = (size_t)blockIdx.x * NTHREADS + tid, gs = (size_t)gridDim.x * NTHREADS;
      const f32x4* xs = (const f32x4*)P.in[0]; f32x4* xd = (f32x4*)P.out;
      for (size_t i = gt; i < (size_t)MLAT * DM / 4; i += gs) xd[i] = xs[i];
      const f32x4* cs = (const f32x4*)P.in[2]; f32x4* cd = (f32x4*)hc;
      for (size_t i = gt; i < (size_t)MCTX * DM / 4; i += gs) cd[i] = cs[i];
      for (size_t i = gt; i < (size_t)SEQ * 32; i += gs) { const int t = (int)(i >> 5), j = (int)(i & 31);
          const float pos = (float)((j < 16) ? (t >> 6) : (t & 63)); const float inv = powf(10000.0f, -(float)(j & 15) / 16.0f); const float ang = pos * inv;
          rope[2 * i] = cosf(ang); rope[2 * i + 1] = sinf(ang); } }
    LAS float* sc = (LAS float*)lds;
    LAS float* part = sc + 9 * 1024;
    for (int i = tid; i < 9 * 1024; i += NTHREADS) { const int idx = i >> 10, k = i & 1023; const float v = idx < 8 ? c[idx * 1024 + k] : cctx[k]; sc[i] = v / (1.f + expf(-v)); }
    __syncthreads();
    for (int item = blockIdx.x; item < 4 * 48; item += gridDim.x) {
        const int l = item / 48, cb = item % 48, col = tid & 127, kq = tid >> 7;
        const float* W = ada_w + (size_t)l * 1024 * 6144 + cb * 128 + col;
        float acc[9];
#pragma unroll
        for (int i = 0; i < 9; ++i) acc[i] = 0.f;
#pragma unroll 8
        for (int k = kq * 256; k < kq * 256 + 256; ++k) { const float wv = W[(size_t)k * 6144];
#pragma unroll
            for (int i = 0; i < 9; ++i) acc[i] += sc[i * 1024 + k] * wv; }
#pragma unroll
        for (int i = 0; i < 9; ++i) part[(kq * 9 + i) * 128 + col] = acc[i];
        __syncthreads();
        for (int o = tid; o < 9 * 128; o += NTHREADS) { const int i = o >> 7, cc = o & 127;
            const float s = (part[(0 * 9 + i) * 128 + cc] + part[(1 * 9 + i) * 128 + cc]) + (part[(2 * 9 + i) * 128 + cc] + part[(3 * 9 + i) * 128 + cc]) + ada_b[l * 6144 + cb * 128 + cc];
            mods[(size_t)(l * 9 + i) * 6144 + cb * 128 + cc] = s; }
        __syncthreads();
    }
}

__global__ void __launch_bounds__(NTHREADS, 2) mega(Params P) {
    extern __shared__ __attribute__((aligned(16))) unsigned char lds_raw[];
    LAS char* lds = (LAS char*)lds_raw;
    cg::grid_group grid = cg::this_grid();
#define THIN_IDS int tid_ = threadIdx.x; asm volatile("" : "+v"(tid_)); const int lane = tid_ & 63, wave = __builtin_amdgcn_readfirstlane(tid_ >> 6); const int gw = blockIdx.x * 8 + wave, NGW = gridDim.x * 8;
    const int lo = P.ph_lo, hi = P.ph_hi;
    int ph = 0;
#define RUN(k) ((k) >= lo && (k) < hi)
#define SEAM(k) do { if ((k) >= lo && (k) + 1 < hi) { if ((k) == 0) { grid.sync(); bar = xcd_barrier_post((unsigned*)(ws + WS_BARW), (volatile LAS unsigned*)(lds + LDS_BYTES - 64)); } else xcd_barrier(bar); } } while (0)
    unsigned char* ws = P.ws;
    float* mods = (float*)(ws + WS_MODS); const float* rope = (const float*)(ws + WS_ROPE); float* hc = (float*)(ws + WS_HC);
    bf16_t* Win = (bf16_t*)(ws + WS_WIN); bf16_t* Wout = (bf16_t*)(ws + WS_WOUT); bf16_t* W1 = (bf16_t*)(ws + WS_W1); bf16_t* W2 = (bf16_t*)(ws + WS_W2);
    bf16_t* Abuf = (bf16_t*)(ws + WS_ABUF); bf16_t* BIG = (bf16_t*)(ws + WS_BIG); bf16_t* HF = (bf16_t*)(ws + WS_HF); bf16_t* HB = (bf16_t*)(ws + WS_HB);
    float* hlat = P.out; float* PART = (float*)(ws + WS_HF);
    XcdBarrier bar; bar.bar = (unsigned*)(ws + WS_BARW); bar.x = 0; bar.st = (volatile LAS unsigned*)(lds + LDS_BYTES - 64);
    if (threadIdx.x < 16) ((volatile LAS unsigned*)(lds + LDS_BYTES - 64))[threadIdx.x] = 0u;
    if (blockIdx.x == 0 && lo == 0) for (int i = threadIdx.x; i < XCD_BAR_WORDS; i += NTHREADS) ((unsigned*)(ws + WS_BARW))[i] = 0u;
    __syncthreads();

    #ifndef REP_P0
#define REP_P0 1
#endif
#ifndef REP_G24
#define REP_G24 1
#endif
#ifndef REP_N1
#define REP_N1 1
#endif
#ifndef REP_N2
#define REP_N2 1
#endif
#ifndef REP_G1
#define REP_G1 1
#endif
#ifndef REP_G3
#define REP_G3 1
#endif
    if (RUN(ph)) for (int rep = 0; rep < REP_P0; ++rep) { p0_phase(P, lds); __syncthreads(); }
    SEAM(ph); ++ph;
#ifdef EXTRA_SYNCS
    if (hi - lo > 1) for (int q = 0; q < EXTRA_SYNCS; ++q) xcd_barrier(bar);
#endif

#pragma unroll 1
    for (int l = 0; l < DEPTH; ++l) {
        const int kind = l % 3, slot = l / 3;
        const bool need_ctx = l < DEPTH - 1;
        const int Mrows = need_ctx ? MTOT : MLAT;
        const int Nin = kind == 0 ? NIN_A : (kind == 1 ? NIN_B : NIN_C);
        const float* modl = mods + (size_t)l * 9 * 6144;
        if (RUN(ph)) for (int rep = 0; rep < REP_N1; ++rep) {
            THIN_IDS
            LAS float* scr = (LAS float*)(lds + wave * 16384);
            ConvDesc cin, cout, c1, c2;
            if (kind == 0) cin = ConvDesc{P.in[10] + (size_t)slot * 1024 * 3104, Win, 1024, 3104, NIN_A, 0, 512, 1024, 0.125f};
            else if (kind == 1) cin = ConvDesc{P.in[14], Win, 1024, 1536, NIN_B, 1280, 0, 1024, 0.125f * 1.4426950408889634f};
            else cin = ConvDesc{P.in[17], Win, 1024, 3072, NIN_C, 2048, 0, 1024, 0.125f * 1.4426950408889634f};
            const float* wo = kind == 0 ? P.in[13] + (size_t)slot * 1024 * 1024 : (kind == 1 ? P.in[16] : P.in[23]);
            cout = ConvDesc{wo, Wout, 1024, 1024, 1024, 0, 0, 0, 1.f};
            c1 = ConvDesc{P.in[8] + (size_t)l * 1024 * 4096, W1, 1024, 4096, 4096, 0, 0, 0, 1.f};
            c2 = ConvDesc{P.in[9] + (size_t)l * 4096 * 1024, W2, 4096, 1024, 1024, 0, 0, 0, 1.f};
            const int n_in = 16 * (Nin / 32), n_out = 16 * 32, n_1 = 16 * 128, n_2 = 64 * 32;
            for (int it = gw; it < n_in + n_out + n_1 + n_2; it += NGW) {
                int rr = it;
                if (rr < n_in) { conv_item(cin, scr, rr, lane); continue; } rr -= n_in;
                if (rr < n_out) { conv_item(cout, scr, rr, lane); continue; } rr -= n_out;
                if (rr < n_1) { conv_item(c1, scr, rr, lane); continue; } rr -= n_1;
                conv_item(c2, scr, rr, lane);
            }
            const float* gn = P.in[6] + l * DM;
            for (int row = gw; row < MTOT; row += NGW) {
                const int idx = row < MLAT ? (row >> 11) : 8;
                float* hrow = row < MLAT ? hlat + (size_t)row * DM : hc + (size_t)(row - MLAT) * DM;
                const bool fold = (row >= MLAT) && (l > 0);
                norm_row(hrow, gn, modl + idx * 6144 + 0 * 1024, modl + idx * 6144 + 1 * 1024, Abuf + (size_t)row * DM, lane,
                         fold ? PART + (size_t)(row - MLAT) * DM : nullptr, 8, (size_t)MCTX * DM, modl - 9 * 6144 + 8 * 6144 + 5 * 1024);
            }
        }
        SEAM(ph); ++ph;
        if (RUN(ph)) for (int rep = 0; rep < REP_G1; ++rep) {
            pg8::Gemm g{Abuf, Win, MTOT, Nin, DM, DM}; pg8::StaticOrder S; S.init(MTOT, Nin, gridDim.x, blockIdx.x);
            EpiQKV E{BIG, Nin, kind == 0 ? 0 : (kind == 1 ? 1280 : 2048), rope};
#ifndef DIS_G1
            pg8::gemm_phase<EpiQKV, pg8::StaticOrder, true, true>((LAS unsigned char*)lds, g, S, E);
#endif
        }
        SEAM(ph); ++ph;
        if (RUN(ph)) {
            if (kind == 0) {
#ifndef DIS_ML
                mlstm_scan(lds, BIG, P.in[11] + slot * 32, HF, HB, need_ctx);
#ifdef DBL_ML
                mlstm_scan(lds, BIG, P.in[11] + slot * 32, HF, HB, need_ctx);
#endif
#endif
            } else if (kind == 1) {
#ifndef DIS_SWA
                swa_phase(lds, BIG, Abuf, P.in[15], need_ctx);
#ifdef DBL_SWA
                swa_phase(lds, BIG, Abuf, P.in[15], need_ctx);
#endif
#endif
            }
            else {
                float s1 = 0.f, s2 = 0.f;
                for (int i = 0; i < 64; ++i) { s1 += P.in[18][i] * P.in[19][i]; s2 += P.in[20][i] * P.in[21][i]; }
                const float lam_init = 0.47071301834358416f;
                const float lam = expf(s1) - expf(s2) + lam_init;
#ifndef DIS_DIFF
                diff_phase(lds, BIG, Abuf, P.in[22], lam, 1.f - lam_init, need_ctx);
#ifdef DBL_DIFF
                diff_phase(lds, BIG, Abuf, P.in[22], lam, 1.f - lam_init, need_ctx);
#endif
#endif
            }
        }
        SEAM(ph); ++ph;
        if (kind == 0) {
            if (RUN(ph)) {
                THIN_IDS
                const float* hn = P.in[12] + slot * 1024;
                for (int row = gw; row < Mrows; row += NGW) mlstm_finish_row(HF, HB, BIG, hn, Abuf, row, lane);
            }
            SEAM(ph);
        }
        ++ph;
        if (RUN(ph)) for (int rep = 0; rep < REP_G24; ++rep) {
            pg8::Gemm g{Abuf, Wout, MLAT, DM, DM, DM}; pg8::StaticOrder S; S.init(MLAT, DM, gridDim.x, blockIdx.x);
            EpiResid E{hlat, hc, modl + 2 * 1024, 1.f / REP_G24};
#ifndef DIS_G2
            pg8::gemm_phase<EpiResid, pg8::StaticOrder, true, true>((LAS unsigned char*)lds, g, S, E);
            if (need_ctx) {
                pg8::Gemm g2{Abuf + (size_t)MLAT * DM, Wout, MCTX, DM, DM / 4, DM}; pg8::SplitOrder S2; S2.init(MCTX, DM, 4, gridDim.x, blockIdx.x);
                EpiPartial E2{PART, MCTX};
                pg8::gemm_phase<EpiPartial, pg8::SplitOrder, true, true>((LAS unsigned char*)lds, g2, S2, E2);
            }
#endif
        }
        SEAM(ph); ++ph;
        if (RUN(ph)) for (int rep = 0; rep < REP_N2; ++rep) {
            THIN_IDS
            const float* gn = P.in[7] + l * DM;
            for (int row = gw; row < Mrows; row += NGW) {
                const int idx = row < MLAT ? (row >> 11) : 8;
                float* hrow = row < MLAT ? hlat + (size_t)row * DM : hc + (size_t)(row - MLAT) * DM;
                const bool fold = (row >= MLAT);
                norm_row(hrow, gn, modl + idx * 6144 + 3 * 1024, modl + idx * 6144 + 4 * 1024, Abuf + (size_t)row * DM, lane,
                         fold ? PART + (size_t)(row - MLAT) * DM : nullptr, 4, (size_t)MCTX * DM, modl + 8 * 6144 + 2 * 1024);
            }
        }
        SEAM(ph); ++ph;
        if (RUN(ph)) for (int rep = 0; rep < REP_G3; ++rep) {
            pg8::Gemm g{Abuf, W1, Mrows, DFF, DM, DM}; pg8::StaticOrder S; S.init(Mrows, DFF, gridDim.x, blockIdx.x);
            EpiSqRelu E{BIG, DFF};
#ifndef DIS_G3
            pg8::gemm_phase<EpiSqRelu, pg8::StaticOrder, true, true>((LAS unsigned char*)lds, g, S, E);
#endif
        }
        SEAM(ph); ++ph;
        if (RUN(ph)) for (int rep = 0; rep < REP_G24; ++rep) {
            pg8::Gemm g{BIG, W2, MLAT, DM, DFF, DFF}; pg8::StaticOrder S; S.init(MLAT, DM, gridDim.x, blockIdx.x);
            EpiResid E{hlat, hc, modl + 5 * 1024, 1.f / REP_G24};
#ifndef DIS_G4
            pg8::gemm_phase<EpiResid, pg8::StaticOrder, true, true>((LAS unsigned char*)lds, g, S, E);
            if (need_ctx) {
                pg8::Gemm g2{BIG + (size_t)MLAT * DFF, W2, MCTX, DM, DFF / 8, DFF}; pg8::SplitOrder S2; S2.init(MCTX, DM, 8, gridDim.x, blockIdx.x);
                EpiPartial E2{PART, MCTX};
                pg8::gemm_phase<EpiPartial, pg8::SplitOrder, true, true>((LAS unsigned char*)lds, g2, S2, E2);
            }
#endif
        }
        SEAM(ph); ++ph;
    }
    if (RUN(ph)) {
        THIN_IDS
        for (int row = gw; row < MLAT; row += NGW) {
            float* hrow = hlat + (size_t)row * DM;
            const f32x4* xr = (const f32x4*)hrow + lane;
            f32x4 v[4]; float s = 0.f;
#pragma unroll
            for (int j = 0; j < 4; ++j) { v[j] = xr[64 * j]; s += (v[j][0] * v[j][0] + v[j][1] * v[j][1]) + (v[j][2] * v[j][2] + v[j][3] * v[j][3]); }
            const float rstd = 1.f / sqrtf(wave_sum(s) * (1.f / DM) + EPS);
#pragma unroll
            for (int j = 0; j < 4; ++j) { const f32x4 gg = ((const f32x4*)P.in[24])[lane + 64 * j]; ((f32x4*)hrow)[lane + 64 * j] = v[j] * rstd * gg; }
        }
    }
#undef RUN
#undef SEAM
}
constexpr int N_PHASES = 1 + 8 * DEPTH + 1;

#ifndef MK_MULTI
#define MK_MULTI 0
#endif
extern "C" void kernel_launch(void* const* d_in, const int* in_sizes, int n_in, void* d_out, int out_size, void* d_ws, size_t ws_size, hipStream_t stream) {
    static int grid = 0;
    if (grid == 0) {
        if (n_in != 25 || ws_size < WS_END) { fprintf(stderr, "kernel_launch: unexpected n_in %d / ws_size %zu\n", n_in, ws_size); grid = -1; return; }
        int dev = 0, cus = 0, per_cu = 0;
        hipGetDevice(&dev); hipDeviceGetAttribute(&cus, hipDeviceAttributeMultiprocessorCount, dev);
        if (hipFuncSetAttribute((const void*)mega, hipFuncAttributeMaxDynamicSharedMemorySize, LDS_BYTES) != hipSuccess) { fprintf(stderr, "hipFuncSetAttribute failed\n"); grid = -1; return; }
        if (hipOccupancyMaxActiveBlocksPerMultiprocessor(&per_cu, (const void*)mega, NTHREADS, LDS_BYTES) != hipSuccess || per_cu < 1) { fprintf(stderr, "occupancy query: %d\n", per_cu); per_cu = 1; }
        (void)hipGetLastError();
        grid = cus * (per_cu > 1 ? 1 : per_cu);
    }
    if (grid < 0) return;
    Params p{};
    for (int i = 0; i < 25; ++i) p.in[i] = (const float*)d_in[i];
    p.out = (float*)d_out; p.ws = (unsigned char*)d_ws;
#if MK_MULTI
    for (int k = 0; k < N_PHASES; ++k) { p.ph_lo = k; p.ph_hi = k + 1; hipLaunchKernelGGL(mega, dim3(grid), dim3(NTHREADS), LDS_BYTES, stream, p); }
#else
    p.ph_lo = 0; p.ph_hi = N_PHASES;
    void* args[] = {&p};
    hipError_t e = hipLaunchCooperativeKernel((const void*)mega, dim3(grid), dim3(NTHREADS), args, LDS_BYTES, stream);
    if (e != hipSuccess) fprintf(stderr, "cooperative launch failed: %s (grid %d)\n", hipGetErrorString(e), grid);
#endif
}
```

```cpp
#include <hip/hip_runtime.h>
#include <hip/hip_cooperative_groups.h>
#include <cstdio>
#include <cstdint>
namespace cg = cooperative_groups;
namespace pg8 {
#define PG8_LAS __attribute__((address_space(3)))
typedef unsigned short bf16_t;
typedef short bf16x8 __attribute__((ext_vector_type(8)));
typedef float f32x4 __attribute__((ext_vector_type(4)));
typedef unsigned u32x4 __attribute__((ext_vector_type(4)));
constexpr int BM = 256, BK = 64, HALF = 128, HTB = HALF * BK * 2  , STAGE_BYTES = 8 * HTB, NXCD = 8, WGM = 8;

__host__ __device__ __forceinline__ int lds_byte(int r, int c) { const int st = (r >> 4) * 2 + (c >> 5), rr = r & 15, cc = c & 31, ob = rr * 64 + cc * 2; return st * 1024 + (ob ^ (((ob >> 9) & 1) << 5)); }
__host__ __device__ __forceinline__ void stage_rc(int b, int& R, int& C) { const int st = b / 1024, sb = b % 1024, swz = sb ^ (((sb >> 9) & 1) << 5); R = (st >> 1) * 16 + swz / 64; C = (st & 1) * 32 + (swz % 64) / 2; }
__host__ __device__ __forceinline__ int perm32(int rho) { const int n = rho >> 4, i = rho & 15; return 8 * (i >> 2) + 4 * n + (i & 3); }

struct Unit { int pm, pn, pk; };
struct Gemm { const bf16_t* A; const bf16_t* Bt; int M, N, K, ldk; };

struct StaticOrder {
    int nM, nN, nwg, G, c;
    __host__ __device__ void init(int M, int N, int G_, int c_) { nM = M / BM; nN = N / BM; nwg = nM * nN; G = G_; c = c_; }
    __host__ __device__ bool next(int i, Unit& u) const {
        const long L = (long)i * G + c; if (L >= nwg) return false;
        int wgid = (int)L; { const int q = nwg / NXCD, r = nwg % NXCD, xcd = wgid % NXCD, off = wgid / NXCD; wgid = (xcd < r ? xcd * (q + 1) : r * (q + 1) + (xcd - r) * q) + off; }
        const int nig = WGM * nN, gid = wgid / nig, fm = gid * WGM, gsz = (nM - fm) < WGM ? (nM - fm) : WGM;
        u.pm = fm + ((wgid % nig) % gsz); u.pn = (wgid % nig) / gsz; u.pk = 0; return true;
    }
    __device__ __forceinline__ void a_ready(const Unit&) const {}
    __device__ __forceinline__ void done(const Unit&) const {}
};

struct SplitOrder {
    int nM, nN, nS, nwg, G, c;
    __host__ __device__ void init(int M, int N, int nS_, int G_, int c_) { nM = M / BM; nN = N / BM; nS = nS_; nwg = nM * nN * nS; G = G_; c = c_; }
    __host__ __device__ bool next(int i, Unit& u) const {
        const long L = (long)i * G + c; if (L >= nwg) return false;
        const int w = (int)L; u.pk = w % nS; const int t = w / nS; u.pn = t % nN; u.pm = t / nN; return true;
    }
    __device__ __forceinline__ void a_ready(const Unit&) const {}
    __device__ __forceinline__ void done(const Unit&) const {}
};

__device__ __forceinline__ unsigned cvt_pk_bf16(float lo, float hi) { unsigned r; asm volatile("v_cvt_pk_bf16_f32 %0, %1, %2" : "=v"(r) : "v"(lo), "v"(hi)); return r; }
template <class Epi, class Sched, bool ALIGN_EPI = false, bool SP2 = false>
__device__ __forceinline__ void gemm_phase(PG8_LAS unsigned char* lds, const Gemm g, const Sched& S, const Epi& E) {
    int tid_o = threadIdx.x; asm volatile("" : "+v"(tid_o)); const int tid = tid_o, wid = __builtin_amdgcn_readfirstlane(tid >> 6), lane = tid & 63, wr = wid >> 2, wc = wid & 3, fr = lane & 15, fq = lane >> 4;
    const int K = g.K, nt = K / BK, LDK = g.ldk;
    unsigned voffA[2], voffB[2];
#pragma unroll
    for (int i = 0; i < 2; ++i) { int R, C; stage_rc(tid * 16 + i * 8192, R, C); const int Rb = Epi::PERM ? ((R & ~31) + perm32(R & 31)) : R;
        voffA[i] = (unsigned)(R * LDK + C) * 2u; voffB[i] = (unsigned)(Rb * LDK + C) * 2u; }
    const size_t kstep = (size_t)(BK * 2);
    const size_t hstep = (size_t)HALF * LDK * 2;
    const size_t tstep = 2 * hstep;
    const unsigned ldsw = (unsigned)wid * 1024u;
    const int aoff = lds_byte(wr * 64 + fr, fq * 8), boff = lds_byte(wc * 32 + fr, fq * 8);
#define PG8_SA(b, h) (((b) * 2 + (h)) * HTB)
#define PG8_SB(b, h) ((4 + (b) * 2 + (h)) * HTB)
#define PG8_STAGE(bufoff, gbase, voff) do { _Pragma("unroll") for (int _i = 0; _i < 2; ++_i) \
        __builtin_amdgcn_global_load_lds((const unsigned*)((const char*)(gbase) + (voff)[_i]), (PG8_LAS unsigned*)(lds + (bufoff) + ldsw + _i * 8192), 16, 0, 0); } while (0)
#define PG8_LDA(dst, b, h) do { _Pragma("unroll") for (int m = 0; m < 4; ++m) _Pragma("unroll") for (int k = 0; k < 2; ++k) dst[m][k] = *(const PG8_LAS bf16x8*)(lds + PG8_SA(b, h) + aoff + m * 2048 + k * 1024); } while (0)
#define PG8_LDB(dst, b, h) do { _Pragma("unroll") for (int n = 0; n < 2; ++n) _Pragma("unroll") for (int k = 0; k < 2; ++k) dst[n][k] = *(const PG8_LAS bf16x8*)(lds + PG8_SB(b, h) + boff + n * 2048 + k * 1024); } while (0)
#define PG8_MMA(ai, bj, At, Bt) do { __builtin_amdgcn_s_setprio(1); _Pragma("unroll") for (int m = 0; m < 4; ++m) _Pragma("unroll") for (int n = 0; n < 2; ++n) _Pragma("unroll") for (int k = 0; k < 2; ++k) \
        acc[ai][bj][m][n] = __builtin_amdgcn_mfma_f32_16x16x32_bf16(Bt[n][k], At[m][k], acc[ai][bj][m][n], 0, 0, 0); __builtin_amdgcn_s_setprio(0); } while (0)
#define PG8_WAIT_V(n) asm volatile("s_waitcnt vmcnt(" #n ")" ::: "memory")
#define PG8_WAIT_L(n) asm volatile("s_waitcnt lgkmcnt(" #n ")" ::: "memory")
#define PG8_BAR __builtin_amdgcn_s_barrier()
#define PG8_SCHED __builtin_amdgcn_sched_barrier(0)
    Unit cur, nxt; int ui = 0;
    if (!S.next(0, cur)) return;
    f32x4 acc[2][2][4][2];
#pragma unroll
    for (int a = 0; a < 2; ++a)
#pragma unroll
        for (int b = 0; b < 2; ++b)
#pragma unroll
            for (int m = 0; m < 4; ++m)
#pragma unroll
                for (int n = 0; n < 2; ++n) acc[a][b][m][n] = (f32x4){0.f, 0.f, 0.f, 0.f};
    bf16x8 At[4][2], B0[2][2], B1[2][2];
    const char* cA = (const char*)g.A + (size_t)cur.pm * tstep + (size_t)cur.pk * K * 2; const char* cB = (const char*)g.Bt + (size_t)cur.pn * tstep + (size_t)cur.pk * K * 2;
    S.a_ready(cur);
    if constexpr (SP2) {
        PG8_STAGE(PG8_SB(0, 0), cB, voffB); PG8_STAGE(PG8_SB(0, 1), cB + hstep, voffB); PG8_STAGE(PG8_SA(0, 0), cA, voffA); PG8_STAGE(PG8_SA(0, 1), cA + hstep, voffA);
        if (wr == 1) PG8_BAR;
        PG8_WAIT_V(2); PG8_BAR;
        PG8_STAGE(PG8_SB(1, 0), cB + kstep, voffB); PG8_STAGE(PG8_SA(1, 0), cA + kstep, voffA); PG8_STAGE(PG8_SB(1, 1), cB + hstep + kstep, voffB);
        PG8_WAIT_V(6); PG8_BAR;
    } else {
        PG8_STAGE(PG8_SB(0, 0), cB, voffB); PG8_STAGE(PG8_SA(0, 0), cA, voffA); PG8_STAGE(PG8_SB(0, 1), cB + hstep, voffB); PG8_STAGE(PG8_SA(0, 1), cA + hstep, voffA);
        if (wr == 1) PG8_BAR;
        PG8_WAIT_V(4); PG8_BAR;
        PG8_STAGE(PG8_SB(1, 0), cB + kstep, voffB); PG8_STAGE(PG8_SA(1, 0), cA + kstep, voffA); PG8_STAGE(PG8_SB(1, 1), cB + hstep + kstep, voffB);
        PG8_WAIT_V(6); PG8_BAR;
    }
    for (;;) {
        const bool has_next = S.next(ui + 1, nxt);
        const char* nA = has_next ? (const char*)g.A + (size_t)nxt.pm * tstep + (size_t)nxt.pk * K * 2 : cA; const char* nB = has_next ? (const char*)g.Bt + (size_t)nxt.pn * tstep + (size_t)nxt.pk * K * 2 : cB;
        for (int t = 0; t < nt; t += 2) {
            const bool last = (t == nt - 2);
            const char* a1 = cA + (size_t)(t + 1) * kstep;
            const char* a2 = last ? nA : cA + (size_t)(t + 2) * kstep; const char* b2 = last ? nB : cB + (size_t)(t + 2) * kstep;
            const char* a3 = a2 + kstep; const char* b3 = b2 + kstep;
            if (last && has_next) S.a_ready(nxt);
            if constexpr (SP2) {
            PG8_LDB(B0, 0, 0); PG8_LDB(B1, 0, 1); PG8_SCHED; PG8_LDA(At, 0, 0); PG8_STAGE(PG8_SA(1, 1), a1 + hstep, voffA);
            PG8_WAIT_V(8); PG8_WAIT_L(0); PG8_BAR; PG8_MMA(0, 0, At, B0); PG8_MMA(0, 1, At, B1); PG8_BAR; PG8_SCHED;
            PG8_LDA(At, 0, 1); PG8_STAGE(PG8_SB(0, 0), b2, voffB); PG8_STAGE(PG8_SB(0, 1), b2 + hstep, voffB); PG8_STAGE(PG8_SA(0, 0), a2, voffA);
            PG8_WAIT_V(8); PG8_WAIT_L(0); PG8_BAR; PG8_MMA(1, 0, At, B0); PG8_MMA(1, 1, At, B1); PG8_BAR; PG8_SCHED;
            PG8_LDB(B0, 1, 0); PG8_LDB(B1, 1, 1); PG8_SCHED; PG8_LDA(At, 1, 0); PG8_STAGE(PG8_SA(0, 1), a2 + hstep, voffA);
            PG8_WAIT_V(8); PG8_WAIT_L(0); PG8_BAR; PG8_MMA(0, 0, At, B0); PG8_MMA(0, 1, At, B1); PG8_BAR; PG8_SCHED;
            PG8_LDA(At, 1, 1); PG8_STAGE(PG8_SB(1, 0), b3, voffB); PG8_STAGE(PG8_SB(1, 1), b3 + hstep, voffB); PG8_STAGE(PG8_SA(1, 0), a3, voffA);
            PG8_WAIT_V(8); PG8_WAIT_L(0); PG8_BAR; PG8_MMA(1, 0, At, B0); PG8_MMA(1, 1, At, B1); PG8_BAR; PG8_SCHED;
            } else {
            PG8_LDB(B0, 0, 0); PG8_SCHED; PG8_LDA(At, 0, 0); PG8_STAGE(PG8_SA(1, 1), a1 + hstep, voffA);
            PG8_WAIT_L(8); PG8_BAR; PG8_WAIT_L(0); PG8_MMA(0, 0, At, B0); PG8_BAR; PG8_SCHED;
            PG8_LDB(B1, 0, 1); PG8_STAGE(PG8_SB(0, 0), b2, voffB);
            PG8_BAR; PG8_WAIT_L(0); PG8_MMA(0, 1, At, B1); PG8_BAR;
            PG8_LDA(At, 0, 1); PG8_STAGE(PG8_SA(0, 0), a2, voffA);
            PG8_BAR; PG8_WAIT_L(0); PG8_MMA(1, 0, At, B0); PG8_BAR; PG8_SCHED;
            PG8_STAGE(PG8_SB(0, 1), b2 + hstep, voffB);
            PG8_WAIT_V(6); PG8_BAR; PG8_MMA(1, 1, At, B1); PG8_BAR;
            PG8_LDB(B0, 1, 0); PG8_SCHED; PG8_LDA(At, 1, 0); PG8_STAGE(PG8_SA(0, 1), a2 + hstep, voffA);
            PG8_WAIT_L(8); PG8_BAR; PG8_WAIT_L(0); PG8_MMA(0, 0, At, B0); PG8_BAR; PG8_SCHED;
            PG8_LDB(B1, 1, 1); PG8_STAGE(PG8_SB(1, 0), b3, voffB);
            PG8_BAR; PG8_WAIT_L(0); PG8_MMA(0, 1, At, B1); PG8_BAR;
            PG8_LDA(At, 1, 1); PG8_STAGE(PG8_SA(1, 0), a3, voffA);
            PG8_BAR; PG8_WAIT_L(0); PG8_MMA(1, 0, At, B0); PG8_BAR; PG8_SCHED;
            PG8_STAGE(PG8_SB(1, 1), b3 + hstep, voffB);
            PG8_WAIT_V(6); PG8_BAR; PG8_MMA(1, 1, At, B1); PG8_BAR;
            }
        }
        if constexpr (ALIGN_EPI) { if (wr == 0) PG8_BAR; }
        if constexpr (!Epi::AFTER_DRAIN) { E(acc, cur, wr, wc, fr, fq); S.done(cur); }
        if (!has_next) break;
#pragma unroll
        for (int a = 0; a < 2; ++a)
#pragma unroll
            for (int b = 0; b < 2; ++b)
#pragma unroll
                for (int m = 0; m < 4; ++m)
#pragma unroll
                    for (int n = 0; n < 2; ++n) acc[a][b][m][n] = (f32x4){0.f, 0.f, 0.f, 0.f};
        cur = nxt; cA = nA; cB = nB; ++ui;
        if constexpr (ALIGN_EPI) { if (wr == 1) PG8_BAR; }
    }
    PG8_WAIT_V(0);
    if constexpr (!ALIGN_EPI) { if (wr == 0) PG8_BAR; }
    PG8_BAR;
    if constexpr (Epi::AFTER_DRAIN) { E.fused(acc, cur, wr, wc, fr, fq, lds, wid, lane); S.done(cur); }
#undef PG8_SA
#undef PG8_SB
#undef PG8_STAGE
#undef PG8_LDA
#undef PG8_LDB
#undef PG8_MMA
#undef PG8_WAIT_V
#undef PG8_WAIT_L
#undef PG8_BAR
#undef PG8_SCHED
}
}
using pg8::bf16_t; using pg8::bf16x8; using pg8::f32x4; using pg8::u32x4;
#define LAS __attribute__((address_space(3)))
#define DI __device__ __forceinline__
typedef short s16x4 __attribute__((ext_vector_type(4)));
typedef short v4i16_t __attribute__((ext_vector_type(4)));
typedef float f32x16 __attribute__((ext_vector_type(16)));
typedef float f32x2_t __attribute__((ext_vector_type(2)));
typedef __bf16 bf16x2_t __attribute__((ext_vector_type(2)));
typedef unsigned u32x2 __attribute__((ext_vector_type(2)));
#define MFMA32(a, b, c) __builtin_amdgcn_mfma_f32_32x32x16_bf16((a), (b), (c), 0, 0, 0)

constexpr int DM = 1024, NB = 8, SEQ = 2048, CTX = 256, DEPTH = 4, DFF = 4096;
constexpr int MLAT = NB * SEQ, MCTX = NB * CTX, MTOT = MLAT + MCTX;
constexpr int NIN_A = 3328, NIN_B = 1536, NIN_C = 3072;
constexpr float EPS = 1e-6f;
constexpr size_t MiB = 1u << 20;
constexpr size_t WS_BARW = 1 * MiB + 768 * 1024;
constexpr size_t WS_MODS = 0, WS_ROPE = 1 * MiB, WS_HC = 2 * MiB, WS_WIN = 10 * MiB, WS_WOUT = 17 * MiB, WS_W1 = 19 * MiB, WS_W2 = 27 * MiB,
                 WS_ABUF = 36 * MiB, WS_BIG = 72 * MiB, WS_HF = 216 * MiB, WS_HB = 252 * MiB, WS_END = 288 * MiB;
constexpr int LDS_BYTES = 147456;
constexpr int NTHREADS = 512;

struct Params { const float* in[25]; float* out; unsigned char* ws; int ph_lo, ph_hi; };

DI unsigned pk2(float lo, float hi) { f32x2_t v = {lo, hi}; bf16x2_t b = __builtin_convertvector(v, bf16x2_t); return __builtin_bit_cast(unsigned, b); }
DI float bflo(unsigned u) { return __uint_as_float(u << 16); }
DI float bfhi(unsigned u) { return __uint_as_float(u & 0xffff0000u); }
DI float bf1(unsigned short u) { return __uint_as_float(((unsigned)u) << 16); }
DI float wave_sum(float v) {
#pragma unroll
    for (int o = 1; o < 64; o <<= 1) v += __shfl_xor(v, o);
    return v;
}
DI int crow(int i, int h) { return (i & 3) + 8 * (i >> 2) + 4 * h; }
DI s16x4 vtr(const LAS char* p) { return __builtin_bit_cast(s16x4, __builtin_amdgcn_ds_read_tr16_b64_v4i16((LAS v4i16_t*)p)); }
DI bf16x8 cat8(s16x4 lo, s16x4 hi) { return __builtin_shufflevector(lo, hi, 0, 1, 2, 3, 4, 5, 6, 7); }
template <int S> DI bf16x8 packP(const f32x16& x) {
    u32x4 p; p.x = pk2(x[8 * S + 0], x[8 * S + 1]); p.y = pk2(x[8 * S + 2], x[8 * S + 3]); p.z = pk2(x[8 * S + 4], x[8 * S + 5]); p.w = pk2(x[8 * S + 6], x[8 * S + 7]);
    return __builtin_bit_cast(bf16x8, p);
}
DI float max3f(float a, float b, float c) { float r; asm("v_max3_f32 %0, %1, %2, %3" : "=v"(r) : "v"(a), "v"(b), "v"(c)); return r; }
#define WG_BAR() do { asm volatile("s_waitcnt lgkmcnt(0)" ::: "memory"); __builtin_amdgcn_s_barrier(); asm volatile("" ::: "memory"); } while (0)
#define LDS_WAIT() asm volatile("s_waitcnt lgkmcnt(0)" ::: "memory")

struct EpiQKV {
    static constexpr bool PERM = true, AFTER_DRAIN = false;
    bf16_t* O; int ldc; int rope_cols; const float* rope;
    DI void operator()(const f32x4 (&acc)[2][2][4][2], const pg8::Unit& u, int wr, int wc, int fr, int fq) const {
        const int row0 = u.pm * 256 + wr * 64 + fr, col0 = u.pn * 256 + wc * 32 + 8 * fq;
        const bool do_rope = (u.pn * 256 < rope_cols) && (u.pm < 64);
#pragma unroll
        for (int ai = 0; ai < 2; ++ai)
#pragma unroll
            for (int m = 0; m < 4; ++m) {
                const int row = row0 + ai * 128 + m * 16; bf16_t* rowp = O + (size_t)row * ldc + col0; const int t = row & 2047;
#pragma unroll
                for (int bj = 0; bj < 2; ++bj) {
                    f32x4 v0 = acc[ai][bj][m][0], v1 = acc[ai][bj][m][1];
                    if (do_rope) {
                        const int j0 = ((col0 + bj * 128) & 63) >> 1;
                        const f32x4 cs0 = *(const f32x4*)(rope + (size_t)(t * 32 + j0) * 2), cs1 = *(const f32x4*)(rope + (size_t)(t * 32 + j0) * 2 + 4);
                        f32x4 r0, r1;
                        r0[0] = v0[0] * cs0[0] - v0[1] * cs0[1]; r0[1] = v0[0] * cs0[1] + v0[1] * cs0[0];
                        r0[2] = v0[2] * cs0[2] - v0[3] * cs0[3]; r0[3] = v0[2] * cs0[3] + v0[3] * cs0[2];
                        r1[0] = v1[0] * cs1[0] - v1[1] * cs1[1]; r1[1] = v1[0] * cs1[1] + v1[1] * cs1[0];
                        r1[2] = v1[2] * cs1[2] - v1[3] * cs1[3]; r1[3] = v1[2] * cs1[3] + v1[3] * cs1[2];
                        v0 = r0; v1 = r1;
                    }
                    u32x4 w; w.x = pk2(v0[0], v0[1]); w.y = pk2(v0[2], v0[3]); w.z = pk2(v1[0], v1[1]); w.w = pk2(v1[2], v1[3]);
                    *(u32x4*)(rowp + bj * 128) = w;
                }
            }
    }
};
struct EpiSqRelu {
    static constexpr bool PERM = true, AFTER_DRAIN = false;
    bf16_t* O; int ldc;
    DI void operator()(const f32x4 (&acc)[2][2][4][2], const pg8::Unit& u, int wr, int wc, int fr, int fq) const {
        const int row0 = u.pm * 256 + wr * 64 + fr, col0 = u.pn * 256 + wc * 32 + 8 * fq;
#pragma unroll
        for (int ai = 0; ai < 2; ++ai)
#pragma unroll
            for (int m = 0; m < 4; ++m) {
                bf16_t* rowp = O + (size_t)(row0 + ai * 128 + m * 16) * ldc + col0;
#pragma unroll
                for (int bj = 0; bj < 2; ++bj) {
                    f32x4 v0 = acc[ai][bj][m][0], v1 = acc[ai][bj][m][1];
#pragma unroll
                    for (int e = 0; e < 4; ++e) { float a = fmaxf(v0[e], 0.f), b = fmaxf(v1[e], 0.f); v0[e] = a * a; v1[e] = b * b; }
                    u32x4 w; w.x = pk2(v0[0], v0[1]); w.y = pk2(v0[2], v0[3]); w.z = pk2(v1[0], v1[1]); w.w = pk2(v1[2], v1[3]);
                    *(u32x4*)(rowp + bj * 128) = w;
                }
            }
    }
};
struct EpiResid {
    static constexpr bool PERM = true, AFTER_DRAIN = false;
    const float* hin; float* hout; const float* gate_base;
    DI void operator()(const f32x4 (&acc)[2][2][4][2], const pg8::Unit& u, int wr, int wc, int fr, int fq) const {
        const int idx = u.pm >> 3;
        const int col0 = u.pn * 256 + wc * 32 + 8 * fq;
        const float* gp = gate_base + idx * 6144 + col0;
        const size_t off0 = ((size_t)u.pm * 256 + wr * 64 + fr) * DM + col0;
#pragma unroll
        for (int bj = 0; bj < 2; ++bj)
#pragma unroll
            for (int n = 0; n < 2; ++n) {
                const f32x4 g = *(const f32x4*)(gp + bj * 128 + 4 * n);
#pragma unroll
                for (int ai = 0; ai < 2; ++ai)
#pragma unroll
                    for (int m = 0; m < 4; ++m) {
                        const size_t off = off0 + (size_t)(ai * 128 + m * 16) * DM + bj * 128 + 4 * n;
                        f32x4 h0 = *(const f32x4*)(hin + off); h0 = h0 + g * acc[ai][bj][m][n]; *(f32x4*)(hout + off) = h0;
                    }
            }
    }
};
struct EpiPartial {
    static constexpr bool PERM = true, AFTER_DRAIN = false;
    float* part; int rows;
    DI void operator()(const f32x4 (&acc)[2][2][4][2], const pg8::Unit& u, int wr, int wc, int fr, int fq) const {
        float* base = part + ((size_t)u.pk * rows + u.pm * 256 + wr * 64 + fr) * DM + u.pn * 256 + wc * 32 + 8 * fq;
#pragma unroll
        for (int ai = 0; ai < 2; ++ai)
#pragma unroll
            for (int m = 0; m < 4; ++m)
#pragma unroll
                for (int bj = 0; bj < 2; ++bj) { float* p = base + (size_t)(ai * 128 + m * 16) * DM + bj * 128; *(f32x4*)p = acc[ai][bj][m][0]; *(f32x4*)(p + 4) = acc[ai][bj][m][1]; }
    }
};

DI void norm_row(float* hrow, const float* g, const float* shift, const float* scale, bf16_t* orow, int lane, const float* part, int nsplit, size_t pstride, const float* pgate) {
    const f32x4* xr = (const f32x4*)hrow + lane;
    f32x4 v[4]; float s = 0.f;
#pragma unroll
    for (int j = 0; j < 4; ++j) v[j] = xr[64 * j];
    if (part) {
#pragma unroll
        for (int j = 0; j < 4; ++j) { f32x4 a = ((const f32x4*)part)[lane + 64 * j];
            for (int q = 1; q < nsplit; ++q) a = a + ((const f32x4*)(part + q * pstride))[lane + 64 * j];
            v[j] = v[j] + ((const f32x4*)pgate)[lane + 64 * j] * a; ((f32x4*)hrow)[lane + 64 * j] = v[j]; }
    }
#pragma unroll
    for (int j = 0; j < 4; ++j) s += (v[j][0] * v[j][0] + v[j][1] * v[j][1]) + (v[j][2] * v[j][2] + v[j][3] * v[j][3]);
    const float rstd = 1.f / sqrtf(wave_sum(s) * (1.f / DM) + EPS);
    u32x2* o8 = (u32x2*)orow + lane;
#pragma unroll
    for (int j = 0; j < 4; ++j) {
        const f32x4 gg = ((const f32x4*)g)[lane + 64 * j];
        f32x4 y = v[j] * rstd * gg;
        const f32x4 sh = ((const f32x4*)shift)[lane + 64 * j], sc = ((const f32x4*)scale)[lane + 64 * j]; y = y * (sc + 1.f) + sh;
        u32x2 w; w.x = pk2(y[0], y[1]); w.y = pk2(y[2], y[3]); o8[64 * j] = w;
    }
}
struct ConvDesc { const float* W; bf16_t* WT; int K, Nsrc, Ndst, rope_cols, sc_lo, sc_hi; float sc_val; };
DI void conv_item(const ConvDesc& d, LAS float* scr, int item, int lane) {
    const int nblk = d.Ndst / 32, kb = item / nblk, nb = item % nblk, k0 = 64 * kb, n0 = 32 * nb;
    const int q = lane & 31, nd = n0 + q;
    int ns = nd;
    if (nd < d.rope_cols) { const int head = nd >> 6, p = nd & 63; ns = head * 64 + (p >> 1) + 32 * (p & 1); }
    const bool valid = ns < d.Nsrc;
    const float scl = (nd >= d.sc_lo && nd < d.sc_hi) ? d.sc_val : 1.f;
    const float* src = d.W + (size_t)k0 * d.Nsrc + (valid ? ns : 0);
#pragma unroll 8
    for (int i = 0; i < 32; ++i) { const int kk = 2 * i + (lane >> 5); const float w = src[(size_t)kk * d.Nsrc]; scr[kk * 33 + q] = valid ? w * scl : 0.f; }
    LDS_WAIT();
    const int c = lane & 7;
#pragma unroll
    for (int j = 0; j < 4; ++j) {
        const int n = (lane >> 3) + 8 * j; const LAS float* s = scr + (8 * c) * 33 + n;
        u32x4 o; o.x = pk2(s[0 * 33], s[1 * 33]); o.y = pk2(s[2 * 33], s[3 * 33]); o.z = pk2(s[4 * 33], s[5 * 33]); o.w = pk2(s[6 * 33], s[7 * 33]);
        *(u32x4*)(d.WT + (size_t)(n0 + n) * d.K + k0 + 8 * c) = o;
    }
    LDS_WAIT();
}
#define XB_TMO      128
#define XB_XCNT(j)  (256  + 64 * (j))
#define XB_XSUB(j)  (1280 + 64 * (j))
#define XB_XGEN(j)  (2304 + 64 * (j))
#define XB_TOP      3328
#define XB_TOPGEN   3392
#define XCD_BAR_WORDS 3456
#define XB_SPIN_CAP (1u << 18)

__device__ __forceinline__ unsigned xb_ld(unsigned* p)              { return __hip_atomic_load(p, __ATOMIC_RELAXED, __HIP_MEMORY_SCOPE_AGENT); }
__device__ __forceinline__ unsigned xb_add(unsigned* p, unsigned v) { return __hip_atomic_fetch_add(p, v, __ATOMIC_RELAXED, __HIP_MEMORY_SCOPE_AGENT); }
__device__ __forceinline__ unsigned xb_xcc_id() { return (unsigned)__builtin_amdgcn_s_getreg((3 << 11) | 20) & 0xFu; }
#define XB_SPIN(cond, bar) do { unsigned _sp = 0; while (cond) { __builtin_amdgcn_s_sleep(1); \
    if ((++_sp & 255u) == 0u) { if (xb_ld(&(bar)[XB_TMO])) break; if (_sp > XB_SPIN_CAP) { atomicAdd(&(bar)[XB_TMO], 1u); break; } } } } while (0)

struct XcdBarrier {
    unsigned* bar; unsigned x;
    volatile __attribute__((address_space(3))) unsigned* st;
};

__device__ __forceinline__ XcdBarrier xcd_barrier_post(unsigned* bar, volatile __attribute__((address_space(3))) unsigned* st) {
    XcdBarrier b; b.bar = bar; b.x = xb_xcc_id(); b.st = st;
    if (threadIdx.x == 0) (void)xb_add(&bar[XB_XCNT(b.x)], 1u);
    return b;
}
__device__ __forceinline__ void xcd_barrier_complete(unsigned* bar, unsigned x, unsigned& nloc, unsigned& nx) {
    const unsigned G = gridDim.x * gridDim.y * gridDim.z;
    unsigned sum, cnt, mine, sp = 0u;
    for (;;) {
        sum = 0u; cnt = 0u; mine = 0u;
#pragma unroll
        for (unsigned j = 0; j < 16; ++j) { const unsigned c = xb_ld(&bar[XB_XCNT(j)]); sum += c; cnt += (c > 0u) ? 1u : 0u; mine = (j == x) ? c : mine; }
        if (sum == G) break;
        __builtin_amdgcn_s_sleep(1);
        if ((++sp & 255u) == 0u) { if (xb_ld(&bar[XB_TMO])) break; if (sp > XB_SPIN_CAP) { atomicAdd(&bar[XB_TMO], 1u); break; } }
    }
    nloc = mine > 0u ? mine : 1u; nx = cnt > 0u ? cnt : 1u;
}

__device__ __forceinline__ void xcd_barrier(const XcdBarrier& b) {
    asm volatile("s_waitcnt vmcnt(0)" ::: "memory");
    __syncthreads();
    if (threadIdx.x == 0) {
        unsigned* bar = b.bar;
        __builtin_amdgcn_s_waitcnt(0);
        unsigned nloc = b.st[0], nx = b.st[1];
        if (nloc == 0u) { xcd_barrier_complete(bar, b.x, nloc, nx); b.st[0] = nloc; b.st[1] = nx; }
        const unsigned old = xb_add(&bar[XB_XSUB(b.x)], 1u);
        const unsigned gen = old / nloc;
        if (old + 1u == (gen + 1u) * nloc) {
            __builtin_amdgcn_fence(__ATOMIC_RELEASE, "agent");
            asm volatile("s_waitcnt vmcnt(0)" ::: "memory");
            const unsigned og = xb_add(&bar[XB_TOP], 1u);
            const unsigned tg = og / nx;
            if (og + 1u == (tg + 1u) * nx) xb_add(&bar[XB_TOPGEN], 1u);
            else XB_SPIN(xb_ld(&bar[XB_TOPGEN]) == tg, bar);
            __builtin_amdgcn_fence(__ATOMIC_ACQUIRE, "agent");
            xb_add(&bar[XB_XGEN(b.x)], 1u);
            asm volatile("s_waitcnt vmcnt(0)" ::: "memory");
        } else {
            XB_SPIN(xb_ld(&bar[XB_XGEN(b.x)]) == gen, bar);
            __builtin_amdgcn_fence(__ATOMIC_ACQUIRE, "agent");
            asm volatile("s_waitcnt vmcnt(0)" ::: "memory");
        }
    }
    __syncthreads();
}
DI void swa_phase(LAS char* lds, const bf16_t* QKV, bf16_t* Obuf, const float* sink, bool need_ctx) {
    int tid_ = threadIdx.x; asm volatile("" : "+v"(tid_)); const int tid = tid_, lane = tid & 63, w = __builtin_amdgcn_readfirstlane(tid >> 6), r = lane & 31, h = lane >> 5;
    const int g = w >> 1, th = w & 1;
    const int i16 = lane & 15, q4 = i16 >> 2, p4 = i16 & 3, g1 = (lane >> 4) & 1;
    LAS char* Kimg = lds; LAS char* Vimg = lds + 9216;
    const int srow = tid >> 3, piece = tid & 7;
    const int nunits = 1024 + (need_ctx ? 128 : 0);
    const int vcu = (gridDim.x % 8 == 0) ? (blockIdx.x & 7) * (gridDim.x >> 3) + (blockIdx.x >> 3) : blockIdx.x;
    for (int u = vcu; u < nunits; u += gridDim.x) {
        int b, kvh, qrow0, t0 = 0, c_lo = 0, n_lat = 0;
        if (u < 1024) { b = u >> 7; kvh = (u >> 5) & 3; t0 = (u & 31) * 64; qrow0 = b * SEQ + t0;
            c_lo = t0 == 0 ? 2 : (t0 == 64 ? 1 : 0); int c_hi = (2176 - t0) / 64; if (c_hi > 5) c_hi = 5; n_lat = c_hi - c_lo; }
        else { const int v = u - 1024; b = v >> 4; kvh = (v >> 2) & 3; qrow0 = MLAT + b * CTX + (v & 3) * 64; }
        const int n = n_lat + 4;
        const int qrow = qrow0 + 32 * th + r, hq = kvh * 4 + g;
        bf16x8 qf[4];
#pragma unroll
        for (int s = 0; s < 4; ++s) qf[s] = *(const bf16x8*)(QKV + (size_t)qrow * NIN_B + hq * 64 + 16 * s + 8 * h);
        float m = sink[hq] * 1.4426950408889634f, l = (h == 0) ? 1.f : 0.f;
        f32x16 O[2];
#pragma unroll
        for (int i = 0; i < 16; ++i) { O[0][i] = 0.f; O[1][i] = 0.f; }
        u32x4 kreg, vreg;
        { const int base = (0 < n_lat) ? b * SEQ + t0 - 128 + 64 * c_lo : MLAT + b * CTX;
          const bf16_t* gp = QKV + (size_t)(base + srow) * NIN_B + kvh * 64 + piece * 8; kreg = *(const u32x4*)(gp + 1024); vreg = *(const u32x4*)(gp + 1280); }
        for (int i = 0; i < n; ++i) {
            WG_BAR();
            *(LAS u32x4*)(Kimg + srow * 144 + piece * 16) = kreg; *(LAS u32x4*)(Vimg + srow * 192 + piece * 16) = vreg;
            WG_BAR();
            if (i + 1 < n) { const int ii = i + 1; const int base = (ii < n_lat) ? b * SEQ + t0 - 128 + 64 * (c_lo + ii) : MLAT + b * CTX + 64 * (ii - n_lat);
                const bf16_t* gp = QKV + (size_t)(base + srow) * NIN_B + kvh * 64 + piece * 8; kreg = *(const u32x4*)(gp + 1024); vreg = *(const u32x4*)(gp + 1280); }
            const bool masked = i < n_lat; const int kpos0 = t0 - 128 + 64 * (c_lo + i), qp = t0 + 32 * th + r;
            {
                f32x16 S0, S1;
#pragma unroll
                for (int e = 0; e < 16; ++e) { S0[e] = 0.f; S1[e] = 0.f; }
#pragma unroll
                for (int s = 0; s < 4; ++s) { const LAS char* kp = Kimg + r * 144 + (16 * s + 8 * h) * 2;
                    const bf16x8 kf0 = *(const LAS bf16x8*)kp, kf1 = *(const LAS bf16x8*)(kp + 32 * 144); S0 = MFMA32(kf0, qf[s], S0); S1 = MFMA32(kf1, qf[s], S1); }
                if (masked) {
#pragma unroll
                    for (int e = 0; e < 16; ++e) { const int d = kpos0 + crow(e, h) - qp; if (d > 128 || d < -128) S0[e] = -INFINITY; if (d + 32 > 128 || d + 32 < -128) S1[e] = -INFINITY; }
                }
                float tmax = fmaxf(S0[0], S1[0]);
#pragma unroll
                for (int e = 1; e < 16; ++e) tmax = fmaxf(tmax, fmaxf(S0[e], S1[e]));
                tmax = fmaxf(tmax, __shfl_xor(tmax, 32));
                if (__any(tmax > m + 8.f)) {
                    const float mn = fmaxf(m, tmax), alpha = __builtin_amdgcn_exp2f(m - mn); m = mn; l *= alpha;
#pragma unroll
                    for (int e = 0; e < 16; ++e) { O[0][e] *= alpha; O[1][e] *= alpha; }
                }
                float ls = 0.f;
#pragma unroll
                for (int e = 0; e < 16; ++e) { S0[e] = __builtin_amdgcn_exp2f(S0[e] - m); S1[e] = __builtin_amdgcn_exp2f(S1[e] - m); ls += S0[e] + S1[e]; }
                l += ls;
                const bf16x8 pa0 = packP<0>(S0), pa1 = packP<1>(S0), pb0 = packP<0>(S1), pb1 = packP<1>(S1);
#pragma unroll
                for (int blk = 0; blk < 2; ++blk) {
                    const LAS char* vp = Vimg + (4 * h + q4) * 192 + 2 * (32 * blk + 16 * g1) + 8 * p4;
                    const bf16x8 vf0 = cat8(vtr(vp), vtr(vp + 8 * 192)), vf1 = cat8(vtr(vp + 16 * 192), vtr(vp + 24 * 192));
                    const bf16x8 vf2 = cat8(vtr(vp + 32 * 192), vtr(vp + 40 * 192)), vf3 = cat8(vtr(vp + 48 * 192), vtr(vp + 56 * 192));
                    O[blk] = MFMA32(vf0, pa0, O[blk]); O[blk] = MFMA32(vf1, pa1, O[blk]); O[blk] = MFMA32(vf2, pb0, O[blk]); O[blk] = MFMA32(vf3, pb1, O[blk]);
                }
            }
        }
        const float inv = 1.f / (l + __shfl_xor(l, 32));
        bf16_t* orow = Obuf + (size_t)qrow * DM + hq * 64 + 4 * h;
#pragma unroll
        for (int blk = 0; blk < 2; ++blk)
#pragma unroll
            for (int ig = 0; ig < 4; ++ig) { u32x2 o; o.x = pk2(O[blk][4 * ig] * inv, O[blk][4 * ig + 1] * inv); o.y = pk2(O[blk][4 * ig + 2] * inv, O[blk][4 * ig + 3] * inv);
                *(u32x2*)(orow + 32 * blk + 8 * ig) = o; }
    }
    __syncthreads();
}

DI void diff_phase(LAS char* lds, const bf16_t* QKV, bf16_t* Obuf, const float* hnorm, float lam, float one_m_lam_init, bool need_ctx) {
    int tid_ = threadIdx.x; asm volatile("" : "+v"(tid_)); const int tid = tid_, lane = tid & 63, w = __builtin_amdgcn_readfirstlane(tid >> 6), r = lane & 31, h = lane >> 5;
    const int mp = w >> 2, tb = w & 3;
    const int i16 = lane & 15, q4 = i16 >> 2, p4 = i16 & 3, g1 = (lane >> 4) & 1;
    constexpr int IMG = 17408, VIMG = 20480;
    LAS char* Kb = lds; LAS char* Vb = lds + 2 * IMG;
    LAS float* X = (LAS float*)(lds + 2 * IMG + 2 * VIMG);
    const int srow = tid >> 3, piece = tid & 7;
    const int wofs = srow * 272 + piece * 16, wofsv = srow * 320 + piece * 16;
    const int nunits = 1024 + (need_ctx ? 128 : 0);
    const int vcu = (gridDim.x % 8 == 0) ? (blockIdx.x & 7) * (gridDim.x >> 3) + (blockIdx.x >> 3) : blockIdx.x;
    for (int u = vcu; u < nunits; u += gridDim.x) {
        int b, hh, qrow0, n_lat;
        if (u < 1024) { b = u >> 7; hh = (u >> 4) & 7; qrow0 = b * SEQ + (u & 15) * 128; n_lat = 32; }
        else { const int v = u - 1024; b = v >> 4; hh = (v >> 1) & 7; qrow0 = MLAT + b * CTX + (v & 1) * 128; n_lat = 0; }
        const int n = n_lat + 4;
        const int qrow = qrow0 + 32 * tb + r;
        const bf16_t* gbase = QKV + (size_t)srow * NIN_C + hh * 128 + piece * 8;
#define DF_ROWS(ii) ((ii) < n_lat ? b * SEQ + 64 * (ii) : MLAT + b * CTX + 64 * ((ii) - n_lat))
#define DF_LOADK(ii) do { const bf16_t* gp_ = gbase + (size_t)DF_ROWS(ii) * NIN_C; kreg[0] = *(const u32x4*)(gp_ + 1024); kreg[1] = *(const u32x4*)(gp_ + 1024 + 64); } while (0)
#define DF_LOADV(ii) do { const bf16_t* gp_ = gbase + (size_t)DF_ROWS(ii) * NIN_C; vreg[0] = *(const u32x4*)(gp_ + 2048); vreg[1] = *(const u32x4*)(gp_ + 2048 + 64); } while (0)
#define DF_WRITEK(buf) do { *(LAS u32x4*)(Kb + (buf) * IMG + wofs) = kreg[0]; *(LAS u32x4*)(Kb + (buf) * IMG + wofs + 128) = kreg[1]; } while (0)
#define DF_WRITEV(buf) do { *(LAS u32x4*)(Vb + (buf) * VIMG + wofsv) = vreg[0]; *(LAS u32x4*)(Vb + (buf) * VIMG + wofsv + 128) = vreg[1]; } while (0)
#define DF_QK(Sa, Sb, buf) do { _Pragma("unroll") for (int s = 0; s < 4; ++s) { const LAS char* kp = Kb + (buf) * IMG + r * 272 + mp * 128 + (16 * s + 8 * h) * 2; \
                const bf16x8 kf0 = *(const LAS bf16x8*)kp, kf1 = *(const LAS bf16x8*)(kp + 32 * 272); \
                if (s == 0) { Sa = MFMA32(kf0, qf[0], negm); Sb = MFMA32(kf1, qf[0], negm); } else { Sa = MFMA32(kf0, qf[s], Sa); Sb = MFMA32(kf1, qf[s], Sb); } } } while (0)
#define DF_ITER(Sa, Sb, Ta, Tb, i) do { const int cur = (i) & 1; \
            if ((i) + 2 < n) DF_WRITEK(cur); \
            if ((i) + 3 < n) DF_LOADK((i) + 3); \
            if ((i) + 1 < n) DF_QK(Ta, Tb, cur ^ 1); \
            float tmax = max3f(Sa[0], Sa[1], Sa[2]); \
            _Pragma("unroll") for (int e = 3; e < 15; e += 2) tmax = max3f(tmax, Sa[e], Sa[e + 1]); \
            tmax = max3f(tmax, Sa[15], Sb[0]); \
            _Pragma("unroll") for (int e = 1; e < 15; e += 2) tmax = max3f(tmax, Sb[e], Sb[e + 1]); \
            tmax = fmaxf(tmax, Sb[15]); tmax = fmaxf(tmax, __shfl_xor(tmax, 32)); \
            if ((i) == 0 || __any(tmax > 8.f)) {     \
                const float d = ((i) == 0) ? tmax : fmaxf(tmax, 0.f), alpha = __builtin_amdgcn_exp2f(-d); l *= alpha; \
                _Pragma("unroll") for (int bk = 0; bk < 4; ++bk) _Pragma("unroll") for (int e = 0; e < 16; ++e) O[bk][e] *= alpha; \
                _Pragma("unroll") for (int e = 0; e < 16; ++e) { Sa[e] -= d; Sb[e] -= d; Ta[e] -= d; Tb[e] -= d; negm[e] -= d; } \
            } \
            float ls = 0.f; \
            _Pragma("unroll") for (int e = 0; e < 16; ++e) { Sa[e] = __builtin_amdgcn_exp2f(Sa[e]); Sb[e] = __builtin_amdgcn_exp2f(Sb[e]); ls += Sa[e] + Sb[e]; } \
            l += ls; \
            const bf16x8 pa0 = packP<0>(Sa), pa1 = packP<1>(Sa), pb0 = packP<0>(Sb), pb1 = packP<1>(Sb); \
            WG_BAR(); \
            if ((i) + 1 < n) DF_WRITEV(cur ^ 1); \
            if ((i) + 2 < n) DF_LOADV((i) + 2); \
            _Pragma("unroll") for (int blk = 0; blk < 4; ++blk) { \
                const LAS char* vp = Vb + cur * VIMG + (4 * h + q4) * 320 + 2 * (32 * blk + 16 * g1) + 8 * p4; \
                const bf16x8 vf0 = cat8(vtr(vp), vtr(vp + 8 * 320)), vf1 = cat8(vtr(vp + 16 * 320), vtr(vp + 24 * 320)); \
                const bf16x8 vf2 = cat8(vtr(vp + 32 * 320), vtr(vp + 40 * 320)), vf3 = cat8(vtr(vp + 48 * 320), vtr(vp + 56 * 320)); \
                O[blk] = MFMA32(vf0, pa0, O[blk]); O[blk] = MFMA32(vf1, pa1, O[blk]); O[blk] = MFMA32(vf2, pb0, O[blk]); O[blk] = MFMA32(vf3, pb1, O[blk]); } \
            WG_BAR(); } while (0)
        bf16x8 qf[4];
#pragma unroll
        for (int s = 0; s < 4; ++s) qf[s] = *(const bf16x8*)(QKV + (size_t)qrow * NIN_C + (hh * 2 + mp) * 64 + 16 * s + 8 * h);
        float l = 0.f;
        f32x16 O[4], negm;
#pragma unroll
        for (int bk = 0; bk < 4; ++bk)
#pragma unroll
            for (int i = 0; i < 16; ++i) O[bk][i] = 0.f;
#pragma unroll
        for (int i = 0; i < 16; ++i) negm[i] = 0.f;
        u32x4 kreg[2], vreg[2];
        f32x16 S0, S1, T0, T1;
        __syncthreads();
        DF_LOADK(0); DF_LOADV(0); DF_WRITEK(0); DF_WRITEV(0);
        DF_LOADK(1); DF_WRITEK(1);
        DF_LOADK(2); DF_LOADV(1);
        __syncthreads();
        DF_QK(S0, S1, 0);
        __syncthreads();
        if (w >= 4) __syncthreads();
        for (int i = 0; i < n; i += 2) { DF_ITER(S0, S1, T0, T1, i); DF_ITER(T0, T1, S0, S1, i + 1); }
        if (w < 4) __syncthreads();
#undef DF_ITER
#undef DF_ROWS
#undef DF_LOADK
#undef DF_LOADV
#undef DF_WRITEK
#undef DF_WRITEV
#undef DF_QK
        const float inv = 1.f / (l + __shfl_xor(l, 32));
        if (mp == 1) {
#pragma unroll
            for (int blk = 0; blk < 4; ++blk)
#pragma unroll
                for (int e = 0; e < 16; ++e) X[(tb * 128 + 32 * blk + crow(e, h)) * 32 + r] = O[blk][e] * inv;
        }
        __syncthreads();
        if (mp == 0) {
            float ss = 0.f;
#pragma unroll
            for (int blk = 0; blk < 4; ++blk)
#pragma unroll
                for (int e = 0; e < 16; ++e) { const float od = O[blk][e] * inv - lam * X[(tb * 128 + 32 * blk + crow(e, h)) * 32 + r]; O[blk][e] = od; ss += od * od; }
            ss += __shfl_xor(ss, 32);
            const float rstd = one_m_lam_init / sqrtf(ss * (1.f / 128.f) + EPS);
            bf16_t* orow = Obuf + (size_t)qrow * DM + hh * 128 + 4 * h; const float* hn = hnorm + hh * 128 + 4 * h;
#pragma unroll
            for (int blk = 0; blk < 4; ++blk)
#pragma unroll
                for (int ig = 0; ig < 4; ++ig) { const f32x4 gn = *(const f32x4*)(hn + 32 * blk + 8 * ig);
                    u32x2 o; o.x = pk2(O[blk][4 * ig] * rstd * gn[0], O[blk][4 * ig + 1] * rstd * gn[1]); o.y = pk2(O[blk][4 * ig + 2] * rstd * gn[2], O[blk][4 * ig + 3] * rstd * gn[3]);
                    *(u32x2*)(orow + 32 * blk + 8 * ig) = o; }
        }
    }
    __syncthreads();
}
DI void mlstm_scan(LAS char* lds, const bf16_t* QKV, const float* gate_b, bf16_t* HF, bf16_t* HB, bool need_ctx) {
    int tid_ = threadIdx.x; asm volatile("" : "+v"(tid_)); const int tid = tid_, lane = tid & 63, w = __builtin_amdgcn_readfirstlane(tid >> 6), r = lane & 31, h = lane >> 5;
    const int dvq = w >> 2, tb = (w < 4) ? w : 7 - w;
    const bool st_wave = tb <= 1; const int dvb = dvq, db = tb;
    const int i16 = lane & 15, q4 = i16 >> 2, p4 = i16 & 3, g1 = (lane >> 4) & 1;
    LAS char* Qimg = lds;
    LAS char* Kimg = lds + 18432;
    LAS char* Vimg = lds + 36864;
    LAS char* Cimg = lds + 61440;
    LAS float* bv = (LAS float*)(lds + 73728);
    LAS float* ev = bv + 18 * 128;
    LAS float* Mv = ev + 18 * 128;
    LAS float* n0 = Mv + 18 * 128;
    LAS float* npart = n0 + 64;
    LAS float* M127 = npart + 512;
    LAS float* blast = M127 + 32;
    for (int it = blockIdx.x; it < 256; it += gridDim.x) {
        const int b = it >> 5, hh = (it >> 2) & 7, dir = (it >> 1) & 1, dvh = it & 1;
        const float gb_i = gate_b[(2 * dir) * 8 + hh], gb_f = gate_b[(2 * dir + 1) * 8 + hh];
        bf16_t* HO = dir ? HB : HF;
        f32x16 Cacc;
#pragma unroll
        for (int e = 0; e < 16; ++e) Cacc[e] = 0.f;
        const int srow = tid >> 2, pc = tid & 3;
        u32x4 qreg[2], kreg[2], vreg[2];
#define ML_BASE(ci) ((ci) < 2 ? MLAT + b * CTX + 128 * (dir ? 1 - (ci) : (ci)) : b * SEQ + 128 * (dir ? 15 - ((ci) - 2) : ((ci) - 2)))
#define ML_LOAD(ci) do { const int base_ = ML_BASE(ci); const int grow_ = dir ? base_ + 127 - srow : base_ + srow; \
            const bf16_t* gp_ = QKV + (size_t)grow_ * NIN_A + hh * 64 + pc * 8; \
            qreg[0] = *(const u32x4*)(gp_); qreg[1] = *(const u32x4*)(gp_ + 32); kreg[0] = *(const u32x4*)(gp_ + 512); kreg[1] = *(const u32x4*)(gp_ + 512 + 32); \
            const bf16_t* gv_ = QKV + (size_t)grow_ * NIN_A + 1024 + hh * 128 + dvh * 64 + pc * 8; \
            vreg[0] = *(const u32x4*)(gv_); vreg[1] = *(const u32x4*)(gv_ + 32); } while (0)
        ML_LOAD(0);
        __syncthreads();
        for (int idx = tid; idx < 18 * 128; idx += NTHREADS) {
            const int ci = idx >> 7, tp = idx & 127; const int base = ML_BASE(ci); const int grow = dir ? base + 127 - tp : base + tp;
            const bf16_t* gg = QKV + (size_t)grow * NIN_A + 3072 + (2 * dir) * 8 + hh;
            const float xi = bf1(gg[0]) + gb_i, xf = bf1(gg[8]) + gb_f;
            ev[idx] = xi; bv[idx] = fminf(xf, 0.f) - __logf(1.f + __expf(-fabsf(xf)));
        }
        __syncthreads();
        for (int ci = w; ci < 18; ci += 8) {
            LAS float* bc = bv + ci * 128; LAS float* ec = ev + ci * 128; LAS float* mc = Mv + ci * 128;
            const float lf0 = bc[2 * lane], lf1 = bc[2 * lane + 1], li0 = ec[2 * lane], li1 = ec[2 * lane + 1];
            const float s2 = lf0 + lf1; float inc = s2;
#pragma unroll
            for (int o = 1; o < 64; o <<= 1) { const float v = __shfl_up(inc, o); if (lane >= o) inc += v; }
            const float b0 = inc - s2 + lf0, b1 = inc;
            const float e0 = li0 - b0, e1 = li1 - b1;
            float mx = fmaxf(e0, e1);
#pragma unroll
            for (int o = 1; o < 64; o <<= 1) { const float v = __shfl_up(mx, o); if (lane >= o) mx = fmaxf(mx, v); }
            float ex = __shfl_up(mx, 1); if (lane == 0) ex = -INFINITY;
            bc[2 * lane] = b0; bc[2 * lane + 1] = b1; ec[2 * lane] = e0; ec[2 * lane + 1] = e1;
            mc[2 * lane] = fmaxf(ex, e0); mc[2 * lane + 1] = mx;
            if (lane == 63) { M127[ci] = mx; blast[ci] = b1; }
        }
        if (tid < 64) n0[tid] = 0.f;
        __syncthreads();
        float m0 = 0.f, dec_prev = 0.f;
        for (int ci = 0; ci < 18; ++ci) {
            const float c127 = fmaxf(M127[ci], m0), dec = __expf(m0 - c127);
            {
                const float us = __expf(ev[ci * 128 + srow] - c127);
                *(LAS u32x4*)(Qimg + srow * 144 + pc * 16) = qreg[0]; *(LAS u32x4*)(Qimg + srow * 144 + 64 + pc * 16) = qreg[1];
#pragma unroll
                for (int k = 0; k < 2; ++k) { u32x4 o;
#pragma unroll
                    for (int e = 0; e < 4; ++e) o[e] = pk2(bflo(kreg[k][e]) * us, bfhi(kreg[k][e]) * us);
                    *(LAS u32x4*)(Kimg + srow * 144 + 64 * k + pc * 16) = o; }
                *(LAS u32x4*)(Vimg + srow * 192 + pc * 16) = vreg[0]; *(LAS u32x4*)(Vimg + srow * 192 + 64 + pc * 16) = vreg[1];
                if (st_wave) {
#pragma unroll
                    for (int ig = 0; ig < 4; ++ig) { u32x2 o; o.x = pk2(Cacc[4 * ig], Cacc[4 * ig + 1]); o.y = pk2(Cacc[4 * ig + 2], Cacc[4 * ig + 3]);
                        *(LAS u32x2*)(Cimg + (32 * db + r) * 192 + 2 * (32 * dvb + 8 * ig + 4 * h)) = o; }
                }
                if (tid < 64 && ci > 0) { float nn = dec_prev * n0[tid];
#pragma unroll
                    for (int p = 0; p < 8; ++p) nn += npart[p * 64 + tid];
                    n0[tid] = nn; }
            }
            WG_BAR();
            if (ci + 1 < 18) ML_LOAD(ci + 1);
            {
                const int t = 32 * tb + r;
                const float c_t = fmaxf(Mv[ci * 128 + t], m0), b_t = bv[ci * 128 + t], r_t = __expf(c127 - c_t);
                bf16x8 qf[4];
#pragma unroll
                for (int ks = 0; ks < 4; ++ks) qf[ks] = *(const LAS bf16x8*)(Qimg + t * 144 + (16 * ks + 8 * h) * 2);
                f32x16 acc;
#pragma unroll
                for (int e = 0; e < 16; ++e) acc[e] = 0.f;
                float dn = 0.f;
#pragma unroll
                for (int ks = 0; ks < 4; ++ks) {
                    const LAS char* cp = Cimg + (16 * ks + 8 * h + q4) * 192 + 2 * (32 * dvq + 16 * g1) + 8 * p4;
                    const bf16x8 cf = cat8(vtr(cp), vtr(cp + 4 * 192));
                    acc = MFMA32(cf, qf[ks], acc);
                    const u32x4 qu = __builtin_bit_cast(u32x4, qf[ks]); const LAS float* np = n0 + 16 * ks + 8 * h;
                    dn += bflo(qu.x) * np[0] + bfhi(qu.x) * np[1] + bflo(qu.y) * np[2] + bfhi(qu.y) * np[3] + bflo(qu.z) * np[4] + bfhi(qu.z) * np[5] + bflo(qu.w) * np[6] + bfhi(qu.w) * np[7];
                }
                dn += __shfl_xor(dn, 32);
#pragma unroll
                for (int e = 0; e < 16; ++e) acc[e] *= dec;
                float dsum = 0.f;
                for (int st = 0; st <= tb; ++st) {
                    f32x16 S;
#pragma unroll
                    for (int e = 0; e < 16; ++e) S[e] = 0.f;
#pragma unroll
                    for (int ks = 0; ks < 4; ++ks) { const bf16x8 kf = *(const LAS bf16x8*)(Kimg + (32 * st + r) * 144 + (16 * ks + 8 * h) * 2); S = MFMA32(kf, qf[ks], S); }
                    if (st == tb) {
#pragma unroll
                        for (int e = 0; e < 16; ++e) if (crow(e, h) > r) S[e] = 0.f;
                    }
#pragma unroll
                    for (int e = 0; e < 16; ++e) dsum += S[e];
                    const bf16x8 pf0 = packP<0>(S), pf1 = packP<1>(S);
                    const LAS char* vp = Vimg + (32 * st + 4 * h + q4) * 192 + 2 * (32 * dvq + 16 * g1) + 8 * p4;
                    const bf16x8 vf0 = cat8(vtr(vp), vtr(vp + 8 * 192)), vf1 = cat8(vtr(vp + 16 * 192), vtr(vp + 24 * 192));
                    acc = MFMA32(vf0, pf0, acc); acc = MFMA32(vf1, pf1, acc);
                }
                dsum += __shfl_xor(dsum, 32);
                const float den = r_t * (dsum + dec * dn);
                const float inv = r_t / fmaxf(fabsf(den), __expf(-(b_t + c_t)));
                if (ci >= 2 || need_ctx) {
                    const int base = ML_BASE(ci); const int orow_i = dir ? base + 127 - t : base + t;
                    bf16_t* orow = HO + (size_t)orow_i * DM + hh * 128 + dvh * 64 + 32 * dvq + 4 * h;
#pragma unroll
                    for (int ig = 0; ig < 4; ++ig) { u32x2 o; o.x = pk2(acc[4 * ig] * inv, acc[4 * ig + 1] * inv); o.y = pk2(acc[4 * ig + 2] * inv, acc[4 * ig + 3] * inv);
                        *(u32x2*)(orow + 8 * ig) = o; }
                }
            }
            if (st_wave) {
#pragma unroll
                for (int e = 0; e < 16; ++e) Cacc[e] *= dec;
#pragma unroll
                for (int ks = 0; ks < 8; ++ks) {
                    const LAS char* vp = Vimg + (16 * ks + 8 * h + q4) * 192 + 2 * (32 * dvb + 16 * g1) + 8 * p4;
                    const bf16x8 vf = cat8(vtr(vp), vtr(vp + 4 * 192));
                    const LAS char* kp = Kimg + (16 * ks + 8 * h + q4) * 144 + 2 * (32 * db + 16 * g1) + 8 * p4;
                    const bf16x8 kf = cat8(vtr(kp), vtr(kp + 4 * 144));
                    Cacc = MFMA32(vf, kf, Cacc);
                }
            }
            {
                const int d = tid & 63; float np_ = 0.f;
#pragma unroll
                for (int s = 0; s < 16; ++s) np_ += bf1(*(const LAS unsigned short*)(Kimg + (16 * w + s) * 144 + 2 * d));
                npart[w * 64 + d] = np_;
            }
            dec_prev = dec; m0 = blast[ci] + c127;
            WG_BAR();
        }
#undef ML_LOAD
#undef ML_BASE
    }
    __syncthreads();
}

DI void mlstm_finish_row(const bf16_t* HF, const bf16_t* HB, const bf16_t* QKV, const float* hnorm, bf16_t* Obuf, int row, int lane) {
    const int c0 = 16 * lane;
    const u32x4 f0 = *(const u32x4*)(HF + (size_t)row * DM + c0), f1 = *(const u32x4*)(HF + (size_t)row * DM + c0 + 8);
    const u32x4 b0 = *(const u32x4*)(HB + (size_t)row * DM + c0), b1 = *(const u32x4*)(HB + (size_t)row * DM + c0 + 8);
    const u32x4 o0 = *(const u32x4*)(QKV + (size_t)row * NIN_A + 2048 + c0), o1 = *(const u32x4*)(QKV + (size_t)row * NIN_A + 2048 + c0 + 8);
    float hs[16], og[16];
#pragma unroll
    for (int k = 0; k < 4; ++k) { hs[2 * k] = bflo(f0[k]) + bflo(b0[k]); hs[2 * k + 1] = bfhi(f0[k]) + bfhi(b0[k]); hs[8 + 2 * k] = bflo(f1[k]) + bflo(b1[k]); hs[8 + 2 * k + 1] = bfhi(f1[k]) + bfhi(b1[k]);
        og[2 * k] = bflo(o0[k]); og[2 * k + 1] = bfhi(o0[k]); og[8 + 2 * k] = bflo(o1[k]); og[8 + 2 * k + 1] = bfhi(o1[k]); }
    float ss = 0.f;
#pragma unroll
    for (int k = 0; k < 16; ++k) ss += hs[k] * hs[k];
    ss += __shfl_xor(ss, 1); ss += __shfl_xor(ss, 2); ss += __shfl_xor(ss, 4);
    const float rstd = 1.f / sqrtf(ss * (1.f / 128.f) + EPS);
    float y[16];
#pragma unroll
    for (int k = 0; k < 16; ++k) y[k] = hs[k] * rstd * hnorm[c0 + k] * (1.f / (1.f + __expf(-og[k])));
    u32x4 w0, w1; w0.x = pk2(y[0], y[1]); w0.y = pk2(y[2], y[3]); w0.z = pk2(y[4], y[5]); w0.w = pk2(y[6], y[7]);
    w1.x = pk2(y[8], y[9]); w1.y = pk2(y[10], y[11]); w1.z = pk2(y[12], y[13]); w1.w = pk2(y[14], y[15]);
    *(u32x4*)(Obuf + (size_t)row * DM + c0) = w0; *(u32x4*)(Obuf + (size_t)row * DM + c0 + 8) = w1;
}
DI void p0_phase(const Params& P, LAS char* lds) {
    int tid_ = threadIdx.x; asm volatile("" : "+v"(tid_)); const int tid = tid_;
    float* mods = (float*)(P.ws + WS_MODS); float* rope = (float*)(P.ws + WS_ROPE); float* hc = (float*)(P.ws + WS_HC);
    const float* c = P.in[1]; const float* cctx = P.in[3]; const float* ada_w = P.in[4]; const float* ada_b = P.in[5];
    { const size_t gt = (size_t)blockIdx.x * NTHREADS + tid, gs = (size_t)gridDim.x * NTHREADS;
      const f32x4* cs = (const f32x4*)P.in[2]; f32x4* cd = (f32x4*)hc;
      for (size_t i = gt; i < (size_t)MCTX * DM / 4; i += gs) cd[i] = cs[i];
      for (size_t i = gt; i < (size_t)SEQ * 32; i += gs) { const int t = (int)(i >> 5), j = (int)(i & 31);
          const float pos = (float)((j < 16) ? (t >> 6) : (t & 63)); const float inv = powf(10000.0f, -(float)(j & 15) / 16.0f); const float ang = pos * inv;
          rope[2 * i] = cosf(ang); rope[2 * i + 1] = sinf(ang); } }
    LAS float* sc = (LAS float*)lds;
    LAS float* part = sc + 9 * 1024;
    for (int i = tid; i < 9 * 1024; i += NTHREADS) { const int idx = i >> 10, k = i & 1023; const float v = idx < 8 ? c[idx * 1024 + k] : cctx[k]; sc[i] = v / (1.f + expf(-v)); }
    __syncthreads();
    for (int item = blockIdx.x; item < 4 * 48; item += gridDim.x) {
        const int l = item / 48, cb = item % 48, col = tid & 127, kq = tid >> 7;
        const float* W = ada_w + (size_t)l * 1024 * 6144 + cb * 128 + col;
        float acc[9];
#pragma unroll
        for (int i = 0; i < 9; ++i) acc[i] = 0.f;
#pragma unroll 8
        for (int k = kq * 256; k < kq * 256 + 256; ++k) { const float wv = W[(size_t)k * 6144];
#pragma unroll
            for (int i = 0; i < 9; ++i) acc[i] += sc[i * 1024 + k] * wv; }
#pragma unroll
        for (int i = 0; i < 9; ++i) part[(kq * 9 + i) * 128 + col] = acc[i];
        __syncthreads();
        for (int o = tid; o < 9 * 128; o += NTHREADS) { const int i = o >> 7, cc = o & 127;
            const float s = (part[(0 * 9 + i) * 128 + cc] + part[(1 * 9 + i) * 128 + cc]) + (part[(2 * 9 + i) * 128 + cc] + part[(3 * 9 + i) * 128 + cc]) + ada_b[l * 6144 + cb * 128 + cc];
            mods[(size_t)(l * 9 + i) * 6144 + cb * 128 + cc] = s; }
        __syncthreads();
    }
}

__global__ void __launch_bounds__(NTHREADS, 2) mega(Params P) {
    extern __shared__ __attribute__((aligned(16))) unsigned char lds_raw[];
    LAS char* lds = (LAS char*)lds_raw;
    cg::grid_group grid = cg::this_grid();
#define THIN_IDS int tid_ = threadIdx.x; asm volatile("" : "+v"(tid_)); const int lane = tid_ & 63, wave = __builtin_amdgcn_readfirstlane(tid_ >> 6); const int gw = blockIdx.x * 8 + wave, NGW = gridDim.x * 8;
    const int lo = P.ph_lo, hi = P.ph_hi;
    int ph = 0;
#define RUN(k) ((k) >= lo && (k) < hi)
#define SEAM(k) do { if ((k) >= lo && (k) + 1 < hi) xcd_barrier(bar); } while (0)
    unsigned char* ws = P.ws;
    float* mods = (float*)(ws + WS_MODS); const float* rope = (const float*)(ws + WS_ROPE); float* hc = (float*)(ws + WS_HC);
    bf16_t* Win = (bf16_t*)(ws + WS_WIN); bf16_t* Wout = (bf16_t*)(ws + WS_WOUT); bf16_t* W1 = (bf16_t*)(ws + WS_W1); bf16_t* W2 = (bf16_t*)(ws + WS_W2);
    bf16_t* Abuf = (bf16_t*)(ws + WS_ABUF); bf16_t* BIG = (bf16_t*)(ws + WS_BIG); bf16_t* HF = (bf16_t*)(ws + WS_HF); bf16_t* HB = (bf16_t*)(ws + WS_HB);
    float* hlat = P.out; float* PART = (float*)(ws + WS_HF);
    XcdBarrier bar; bar.bar = (unsigned*)(ws + WS_BARW); bar.x = 0; bar.st = (volatile LAS unsigned*)(lds + LDS_BYTES - 64);
    if (threadIdx.x < 16) ((volatile LAS unsigned*)(lds + LDS_BYTES - 64))[threadIdx.x] = 0u;
    __syncthreads();
    if (lo < 0) grid.sync();
    if (hi - lo > 1) bar = xcd_barrier_post((unsigned*)(ws + WS_BARW), (volatile LAS unsigned*)(lds + LDS_BYTES - 64));

    #ifndef REP_P0
#define REP_P0 1
#endif
#ifndef REP_G24
#define REP_G24 1
#endif
#ifndef REP_N1
#define REP_N1 1
#endif
#ifndef REP_N2
#define REP_N2 1
#endif
#ifndef REP_G1
#define REP_G1 1
#endif
#ifndef REP_G3
#define REP_G3 1
#endif
    if (RUN(ph)) for (int rep = 0; rep < REP_P0; ++rep) { p0_phase(P, lds); __syncthreads(); }
    SEAM(ph); ++ph;
#ifdef EXTRA_SYNCS
    if (hi - lo > 1) for (int q = 0; q < EXTRA_SYNCS; ++q) xcd_barrier(bar);
#endif

#pragma unroll 1
    for (int l = 0; l < DEPTH; ++l) {
        const int kind = l % 3, slot = l / 3;
        const bool need_ctx = l < DEPTH - 1;
        const int Mrows = need_ctx ? MTOT : MLAT;
        const int Nin = kind == 0 ? NIN_A : (kind == 1 ? NIN_B : NIN_C);
        const float* modl = mods + (size_t)l * 9 * 6144;
        if (RUN(ph)) for (int rep = 0; rep < REP_N1; ++rep) {
            THIN_IDS
            LAS float* scr = (LAS float*)(lds + wave * 16384);
            ConvDesc cin, cout, c1, c2;
            if (kind == 0) cin = ConvDesc{P.in[10] + (size_t)slot * 1024 * 3104, Win, 1024, 3104, NIN_A, 0, 512, 1024, 0.125f};
            else if (kind == 1) cin = ConvDesc{P.in[14], Win, 1024, 1536, NIN_B, 1280, 0, 1024, 0.125f * 1.4426950408889634f};
            else cin = ConvDesc{P.in[17], Win, 1024, 3072, NIN_C, 2048, 0, 1024, 0.125f * 1.4426950408889634f};
            const float* wo = kind == 0 ? P.in[13] + (size_t)slot * 1024 * 1024 : (kind == 1 ? P.in[16] : P.in[23]);
            cout = ConvDesc{wo, Wout, 1024, 1024, 1024, 0, 0, 0, 1.f};
            c1 = ConvDesc{P.in[8] + (size_t)l * 1024 * 4096, W1, 1024, 4096, 4096, 0, 0, 0, 1.f};
            c2 = ConvDesc{P.in[9] + (size_t)l * 4096 * 1024, W2, 4096, 1024, 1024, 0, 0, 0, 1.f};
            const int n_in = 16 * (Nin / 32), n_out = 16 * 32, n_1 = 16 * 128, n_2 = 64 * 32;
            for (int it = gw; it < n_in + n_out + n_1 + n_2; it += NGW) {
                int rr = it;
                if (rr < n_in) { conv_item(cin, scr, rr, lane); continue; } rr -= n_in;
                if (rr < n_out) { conv_item(cout, scr, rr, lane); continue; } rr -= n_out;
                if (rr < n_1) { conv_item(c1, scr, rr, lane); continue; } rr -= n_1;
                conv_item(c2, scr, rr, lane);
            }
            const float* gn = P.in[6] + l * DM;
            for (int row = gw; row < MTOT; row += NGW) {
                const int idx = row < MLAT ? (row >> 11) : 8;
                float* hrow = row < MLAT ? (l == 0 ? const_cast<float*>(P.in[0]) : hlat) + (size_t)row * DM : hc + (size_t)(row - MLAT) * DM;
                const bool fold = (row >= MLAT) && (l > 0);
                norm_row(hrow, gn, modl + idx * 6144 + 0 * 1024, modl + idx * 6144 + 1 * 1024, Abuf + (size_t)row * DM, lane,
                         fold ? PART + (size_t)(row - MLAT) * DM : nullptr, 8, (size_t)MCTX * DM, modl - 9 * 6144 + 8 * 6144 + 5 * 1024);
            }
        }
        SEAM(ph); ++ph;
        if (RUN(ph)) for (int rep = 0; rep < REP_G1; ++rep) {
            pg8::Gemm g{Abuf, Win, MTOT, Nin, DM, DM}; pg8::StaticOrder S; S.init(MTOT, Nin, gridDim.x, blockIdx.x);
            EpiQKV E{BIG, Nin, kind == 0 ? 0 : (kind == 1 ? 1280 : 2048), rope};
#ifndef DIS_G1
            pg8::gemm_phase<EpiQKV, pg8::StaticOrder, true, true>((LAS unsigned char*)lds, g, S, E);
#endif
        }
        SEAM(ph); ++ph;
        if (RUN(ph)) {
            if (kind == 0) {
#ifndef DIS_ML
                mlstm_scan(lds, BIG, P.in[11] + slot * 32, HF, HB, need_ctx);
#ifdef DBL_ML
                mlstm_scan(lds, BIG, P.in[11] + slot * 32, HF, HB, need_ctx);
#endif
#endif
            } else if (kind == 1) {
#ifndef DIS_SWA
                swa_phase(lds, BIG, Abuf, P.in[15], need_ctx);
#ifdef DBL_SWA
                swa_phase(lds, BIG, Abuf, P.in[15], need_ctx);
#endif
#endif
            }
            else {
                float s1 = 0.f, s2 = 0.f;
                for (int i = 0; i < 64; ++i) { s1 += P.in[18][i] * P.in[19][i]; s2 += P.in[20][i] * P.in[21][i]; }
                const float lam_init = 0.47071301834358416f;
                const float lam = expf(s1) - expf(s2) + lam_init;
#ifndef DIS_DIFF
                diff_phase(lds, BIG, Abuf, P.in[22], lam, 1.f - lam_init, need_ctx);
#ifdef DBL_DIFF
                diff_phase(lds, BIG, Abuf, P.in[22], lam, 1.f - lam_init, need_ctx);
#endif
#endif
            }
        }
        SEAM(ph); ++ph;
        if (kind == 0) {
            if (RUN(ph)) {
                THIN_IDS
                const float* hn = P.in[12] + slot * 1024;
                for (int row = gw; row < Mrows; row += NGW) mlstm_finish_row(HF, HB, BIG, hn, Abuf, row, lane);
            }
            SEAM(ph);
        }
        ++ph;
        if (RUN(ph)) {
            pg8::Gemm g{Abuf, Wout, MLAT, DM, DM, DM}; pg8::StaticOrder S; S.init(MLAT, DM, gridDim.x, blockIdx.x);
            EpiResid E{l == 0 ? P.in[0] : hlat, hlat, modl + 2 * 1024};
#ifndef DIS_G2
            pg8::gemm_phase<EpiResid, pg8::StaticOrder, false, true>((LAS unsigned char*)lds, g, S, E);
            if (need_ctx) {
                pg8::Gemm g2{Abuf + (size_t)MLAT * DM, Wout, MCTX, DM, DM / 4, DM}; pg8::SplitOrder S2; S2.init(MCTX, DM, 4, gridDim.x, blockIdx.x);
                EpiPartial E2{PART, MCTX};
                pg8::gemm_phase<EpiPartial, pg8::SplitOrder, true, true>((LAS unsigned char*)lds, g2, S2, E2);
            }
#endif
        }
        SEAM(ph); ++ph;
        if (RUN(ph)) for (int rep = 0; rep < REP_N2; ++rep) {
            THIN_IDS
            const float* gn = P.in[7] + l * DM;
            for (int row = gw; row < Mrows; row += NGW) {
                const int idx = row < MLAT ? (row >> 11) : 8;
                float* hrow = row < MLAT ? hlat + (size_t)row * DM : hc + (size_t)(row - MLAT) * DM;
                const bool fold = (row >= MLAT);
                norm_row(hrow, gn, modl + idx * 6144 + 3 * 1024, modl + idx * 6144 + 4 * 1024, Abuf + (size_t)row * DM, lane,
                         fold ? PART + (size_t)(row - MLAT) * DM : nullptr, 4, (size_t)MCTX * DM, modl + 8 * 6144 + 2 * 1024);
            }
        }
        SEAM(ph); ++ph;
        if (RUN(ph)) for (int rep = 0; rep < REP_G3; ++rep) {
            pg8::Gemm g{Abuf, W1, Mrows, DFF, DM, DM}; pg8::StaticOrder S; S.init(Mrows, DFF, gridDim.x, blockIdx.x);
            EpiSqRelu E{BIG, DFF};
#ifndef DIS_G3
            pg8::gemm_phase<EpiSqRelu, pg8::StaticOrder, true, true>((LAS unsigned char*)lds, g, S, E);
#endif
        }
        SEAM(ph); ++ph;
        if (RUN(ph)) {
            pg8::Gemm g{BIG, W2, MLAT, DM, DFF, DFF}; pg8::StaticOrder S; S.init(MLAT, DM, gridDim.x, blockIdx.x);
            EpiResid E{hlat, hlat, modl + 5 * 1024};
#ifndef DIS_G4
            pg8::gemm_phase<EpiResid, pg8::StaticOrder, false, true>((LAS unsigned char*)lds, g, S, E);
            if (need_ctx) {
                pg8::Gemm g2{BIG + (size_t)MLAT * DFF, W2, MCTX, DM, DFF / 8, DFF}; pg8::SplitOrder S2; S2.init(MCTX, DM, 8, gridDim.x, blockIdx.x);
                EpiPartial E2{PART, MCTX};
                pg8::gemm_phase<EpiPartial, pg8::SplitOrder, true, true>((LAS unsigned char*)lds, g2, S2, E2);
            }
#endif
        }
        SEAM(ph); ++ph;
    }
    if (RUN(ph)) {
        THIN_IDS
        for (int row = gw; row < MLAT; row += NGW) {
            float* hrow = hlat + (size_t)row * DM;
            const f32x4* xr = (const f32x4*)hrow + lane;
            f32x4 v[4]; float s = 0.f;
#pragma unroll
            for (int j = 0; j < 4; ++j) { v[j] = xr[64 * j]; s += (v[j][0] * v[j][0] + v[j][1] * v[j][1]) + (v[j][2] * v[j][2] + v[j][3] * v[j][3]); }
            const float rstd = 1.f / sqrtf(wave_sum(s) * (1.f / DM) + EPS);
#pragma unroll
            for (int j = 0; j < 4; ++j) { const f32x4 gg = ((const f32x4*)P.in[24])[lane + 64 * j]; ((f32x4*)hrow)[lane + 64 * j] = v[j] * rstd * gg; }
        }
    }
#undef RUN
#undef SEAM
}
constexpr int N_PHASES = 1 + 8 * DEPTH + 1;

#ifndef MK_MULTI
#define MK_MULTI 0
#endif
extern "C" void kernel_launch(void* const* d_in, const int* in_sizes, int n_in, void* d_out, int out_size, void* d_ws, size_t ws_size, hipStream_t stream) {
    static int grid = 0;
    if (grid == 0) {
        if (n_in != 25 || ws_size < WS_END) { fprintf(stderr, "kernel_launch: unexpected n_in %d / ws_size %zu\n", n_in, ws_size); grid = -1; return; }
        int dev = 0, cus = 0, per_cu = 0;
        hipGetDevice(&dev); hipDeviceGetAttribute(&cus, hipDeviceAttributeMultiprocessorCount, dev);
        if (hipFuncSetAttribute((const void*)mega, hipFuncAttributeMaxDynamicSharedMemorySize, LDS_BYTES) != hipSuccess) { fprintf(stderr, "hipFuncSetAttribute failed\n"); grid = -1; return; }
        if (hipOccupancyMaxActiveBlocksPerMultiprocessor(&per_cu, (const void*)mega, NTHREADS, LDS_BYTES) != hipSuccess || per_cu < 1) { fprintf(stderr, "occupancy query: %d\n", per_cu); per_cu = 1; }
        (void)hipGetLastError();
        grid = cus * (per_cu > 1 ? 1 : per_cu);
    }
    if (grid < 0) return;
    Params p{};
    for (int i = 0; i < 25; ++i) p.in[i] = (const float*)d_in[i];
    p.out = (float*)d_out; p.ws = (unsigned char*)d_ws;
#if MK_MULTI
    for (int k = 0; k < N_PHASES; ++k) { p.ph_lo = k; p.ph_hi = k + 1; hipLaunchKernelGGL(mega, dim3(grid), dim3(NTHREADS), LDS_BYTES, stream, p); }
#else
    p.ph_lo = 0; p.ph_hi = N_PHASES;
    if (hipMemsetAsync((unsigned char*)d_ws + WS_BARW, 0, XCD_BAR_WORDS * 4, stream) != hipSuccess) { fprintf(stderr, "memset failed\n"); return; }
    void* args[] = {&p};
    hipError_t e = hipLaunchCooperativeKernel((const void*)mega, dim3(grid), dim3(NTHREADS), args, LDS_BYTES, stream);
    if (e != hipSuccess) fprintf(stderr, "cooperative launch failed: %s (grid %d)\n", hipGetErrorString(e), grid);
#endif
}
```
